# Optimizing an MI355X kernel written in HIP

```python
import math
import jax, jax.numpy as jnp
from jax import lax
import numpy as np

D_MODEL = 1024
BATCH = 2
SEQ = 16384
DEPTH = 1
DEC_BATCH = 32
DEC_SEQ = 16
PAST_LEN = 2048

CHUNK = 64
Q_BLOCK = 128
EPS = 1e-6

MLA_HEADS = 8
QK_NOPE = 64
QK_ROPE = 32
V_HEAD = 64
Q_LORA = 384
KV_LORA = 256
ROPE_THETA = 10000.0
MLA_WIDTH = MLA_HEADS * V_HEAD
MLA_SCALE = 1.0 / math.sqrt(QK_NOPE + QK_ROPE)

HG_HEADS = 4
HG_EXPAND = 128
HG_VDIM = 128
HG_WIDTH = HG_HEADS * HG_EXPAND
HG_SCALE = 1.0 / math.sqrt(HG_EXPAND)

D_FF = ((8 * D_MODEL // 3 + 255) // 256) * 256

IN_SIZES = (Q_LORA, KV_LORA, QK_ROPE, HG_WIDTH, HG_WIDTH, HG_WIDTH, HG_WIDTH, D_MODEL, D_MODEL)
IN_DIM = sum(IN_SIZES)
IN_OFFSETS = tuple(int(v) for v in np.cumsum(IN_SIZES)[:-1])

kernel_name = "hybrid_mla_hgrn2_streaming_step"


def rms_norm(x, w):
    xf = x.astype(jnp.float32)
    y = xf * lax.rsqrt(jnp.mean(xf * xf, axis=-1, keepdims=True) + EPS)
    return (y * w.astype(jnp.float32)).astype(x.dtype)


def rope(x, pos):
    half = x.shape[-1] // 2
    inv = ROPE_THETA ** (-jnp.arange(half, dtype=jnp.float32) / half)
    ang = pos.astype(jnp.float32)[:, None] * inv[None, :]
    shp = (1, pos.shape[0]) + (1,) * (x.ndim - 3) + (half,)
    cos = jnp.cos(ang).reshape(shp)
    sin = jnp.sin(ang).reshape(shp)
    xf = x.astype(jnp.float32)
    x1, x2 = xf[..., :half], xf[..., half:]
    return jnp.concatenate([x1 * cos - x2 * sin, x1 * sin + x2 * cos], axis=-1).astype(x.dtype)


def chunk_attention(q, k, v, q_chunk, k_chunk):
    s = jnp.einsum('bqhd,bkhd->bhqk', q, k).astype(jnp.float32) * MLA_SCALE
    mask = k_chunk[None, :] <= q_chunk[:, None]
    s = jnp.where(mask[None, None], s, -jnp.inf)
    p = jax.nn.softmax(s, axis=-1).astype(v.dtype)
    return jnp.einsum('bhqk,bkhd->bqhd', p, v)


def hgrn2_recurrence(q, k, v, g, s0, block):
    B, T, H, K = q.shape
    V = v.shape[-1]
    nb = T // block
    f32 = jnp.float32

    def to_blocks(a):
        return a.astype(f32).reshape(B, nb, block, H, a.shape[-1]).transpose(1, 0, 3, 2, 4)

    tri = jnp.tril(jnp.ones((block, block), dtype=bool))[None, None, :, :, None]

    def step(S, blk):
        qb, kb, vb, gb = blk
        bc = jnp.cumsum(gb, axis=2)
        diff = bc[:, :, :, None, :] - bc[:, :, None, :, :]
        dec = jnp.exp(jnp.where(tri, diff, -jnp.inf))
        att = jnp.einsum('bhtk,bhsk,bhtsk->bhts', qb, kb, dec)
        o = (jnp.einsum('bhts,bhsv->bhtv', att, vb)
             + jnp.einsum('bhtk,bhkv->bhtv', qb * jnp.exp(bc), S))
        last = bc[:, :, -1:, :]
        S = (jnp.exp(last[:, :, 0, :])[..., None] * S
             + jnp.einsum('bhsk,bhsv->bhkv', kb * jnp.exp(last - bc), vb))
        return S, o

    S, o = lax.scan(step, s0.astype(f32), (to_blocks(q), to_blocks(k), to_blocks(v), to_blocks(g)))
    o = o.transpose(1, 0, 3, 2, 4).reshape(B, T, H, V)
    return o, S


def token_mixers(h, pos, p, l, past_ckv, past_krope, s0, hg_block):
    B, T, _ = h.shape
    z = h @ p["w_in"][l]
    q_lat, kv_lat, kr_raw, hq, hf, hi, hgate, ga, gb = jnp.split(z, IN_OFFSETS, axis=-1)

    c_q = rms_norm(q_lat, p["q_norm"][l])
    q = (c_q @ p["w_uq"][l]).reshape(B, T, MLA_HEADS, QK_NOPE + QK_ROPE)
    q = jnp.concatenate([q[..., :QK_NOPE], rope(q[..., QK_NOPE:], pos)], axis=-1)
    c_kv = rms_norm(kv_lat, p["kv_norm"][l])
    k_rope = rope(kr_raw, pos)
    if past_ckv is None:
        all_ckv, all_kr, k_pos = c_kv, k_rope, pos
    else:
        all_ckv = jnp.concatenate([past_ckv.astype(c_kv.dtype), c_kv], axis=1)
        all_kr = jnp.concatenate([past_krope.astype(k_rope.dtype), k_rope], axis=1)
        k_pos = jnp.arange(all_ckv.shape[1], dtype=jnp.int32)
    Tk = all_ckv.shape[1]
    kv = (all_ckv @ p["w_ukv"][l]).reshape(B, Tk, MLA_HEADS, QK_NOPE + V_HEAD)
    k = jnp.concatenate([kv[..., :QK_NOPE],
                         jnp.broadcast_to(all_kr[:, :, None, :], (B, Tk, MLA_HEADS, QK_ROPE))], axis=-1)
    v = kv[..., QK_NOPE:]
    q_chunk = pos // CHUNK
    k_chunk = k_pos // CHUNK
    if T <= Q_BLOCK:
        attn = chunk_attention(q, k, v, q_chunk, k_chunk)
    else:
        nqb = T // Q_BLOCK
        qb = q.reshape(B, nqb, Q_BLOCK, MLA_HEADS, QK_NOPE + QK_ROPE).transpose(1, 0, 2, 3, 4)
        qc = q_chunk.reshape(nqb, Q_BLOCK)
        attn = lax.map(lambda a: chunk_attention(a[0], k, v, a[1], k_chunk), (qb, qc))
        attn = attn.transpose(1, 0, 2, 3, 4).reshape(B, T, MLA_HEADS, V_HEAD)

    lb = jnp.cumsum(jax.nn.softmax(p["lb_param"].astype(jnp.float32), axis=0), axis=0)[l]
    hf32 = hf.astype(jnp.float32)
    log_f = jnp.log(lb + (1.0 - lb) * jax.nn.sigmoid(hf32))
    k_in = (1.0 - lb) * jax.nn.sigmoid(-hf32)
    qh = jax.nn.silu(hq.astype(jnp.float32)) * HG_SCALE
    rs = lambda a, d: a.reshape(B, T, HG_HEADS, d)
    o, s_new = hgrn2_recurrence(rs(qh, HG_EXPAND), rs(k_in, HG_EXPAND), rs(hi, HG_VDIM),
                                rs(log_f, HG_EXPAND), s0, hg_block)
    o = rms_norm(o.astype(h.dtype), p["hg_norm"][l]) * jax.nn.silu(rs(hgate, HG_VDIM))

    y_a = attn.reshape(B, T, MLA_WIDTH) @ p["w_pa"][l]
    y_b = o.reshape(B, T, HG_HEADS * HG_VDIM) @ p["w_pb"][l]
    mixed = jax.nn.sigmoid(ga) * y_a + jax.nn.sigmoid(gb) * y_b
    return mixed @ p["w_out"][l], c_kv, k_rope, s_new


def trunk(x, c, pos, p, caches_ckv, caches_kr, states, hg_block):
    B = x.shape[0]
    new_ckv, new_kr, new_s = [], [], []
    for l in range(DEPTH):
        mod = jax.nn.silu(c) @ p["w_ada"][l] + p["b_ada"][l]
        sh1, sc1, g1, sh2, sc2, g2 = [t[:, None, :] for t in jnp.split(mod, 6, axis=-1)]
        h = rms_norm(x, p["norm1"][l]) * (1.0 + sc1) + sh1
        if caches_ckv is None:
            past_ckv, past_kr = None, None
            s0 = jnp.zeros((B, HG_HEADS, HG_EXPAND, HG_VDIM), dtype=jnp.float32)
        else:
            past_ckv, past_kr, s0 = caches_ckv[l], caches_kr[l], states[l]
        m, ckv, kr, s = token_mixers(h, pos, p, l, past_ckv, past_kr, s0, hg_block)
        x = x + g1 * m
        h = rms_norm(x, p["norm2"][l]) * (1.0 + sc2) + sh2
        gate, up = jnp.split(h @ p["w_gu"][l], 2, axis=-1)
        x = x + g2 * ((jax.nn.silu(gate) * up) @ p["w_down"][l])
        new_ckv.append(ckv)
        new_kr.append(kr)
        new_s.append(s.astype(x.dtype))
    y = rms_norm(x, p["final_norm"])
    return y, jnp.stack(new_ckv), jnp.stack(new_kr), jnp.stack(new_s)


def setup_inputs(seed: int = 0) -> dict:
    key = jax.random.key(seed)
    ks = jax.random.split(key, 32)
    f32 = jnp.float32
    nrm = lambda k, shape, s: jax.random.normal(k, shape, f32) * s
    gain = lambda k, shape: 1.0 + 0.02 * jax.random.normal(k, shape, f32)
    return {
        "x_prompt": nrm(ks[0], (BATCH, SEQ, D_MODEL), 1.0),
        "x_sample": nrm(ks[1], (DEC_BATCH, DEC_SEQ, D_MODEL), 1.0),
        "cache_ckv": nrm(ks[2], (DEPTH, DEC_BATCH, PAST_LEN, KV_LORA), 1.0),
        "cache_krope": nrm(ks[3], (DEPTH, DEC_BATCH, PAST_LEN, QK_ROPE), 1.0),
        "state_hgrn": nrm(ks[4], (DEPTH, DEC_BATCH, HG_HEADS, HG_EXPAND, HG_VDIM), 0.3),
        "c_prompt": nrm(ks[5], (BATCH, D_MODEL), 1.0),
        "c_sample": nrm(ks[6], (DEC_BATCH, D_MODEL), 1.0),
        "w_in": nrm(ks[7], (DEPTH, D_MODEL, IN_DIM), D_MODEL ** -0.5),
        "q_norm": gain(ks[8], (DEPTH, Q_LORA)),
        "w_uq": nrm(ks[9], (DEPTH, Q_LORA, MLA_HEADS * (QK_NOPE + QK_ROPE)), Q_LORA ** -0.5),
        "kv_norm": gain(ks[10], (DEPTH, KV_LORA)),
        "w_ukv": nrm(ks[11], (DEPTH, KV_LORA, MLA_HEADS * (QK_NOPE + V_HEAD)), KV_LORA ** -0.5),
        "lb_param": nrm(ks[12], (DEPTH + 1, HG_WIDTH), 0.5),
        "hg_norm": gain(ks[13], (DEPTH, HG_VDIM)),
        "w_pa": nrm(ks[14], (DEPTH, MLA_WIDTH, D_MODEL), MLA_WIDTH ** -0.5),
        "w_pb": nrm(ks[15], (DEPTH, HG_HEADS * HG_VDIM, D_MODEL), (HG_HEADS * HG_VDIM) ** -0.5),
        "w_out": nrm(ks[16], (DEPTH, D_MODEL, D_MODEL), D_MODEL ** -0.5),
        "norm1": gain(ks[17], (DEPTH, D_MODEL)),
        "norm2": gain(ks[18], (DEPTH, D_MODEL)),
        "w_ada": nrm(ks[19], (DEPTH, D_MODEL, 6 * D_MODEL), 0.5 * D_MODEL ** -0.5),
        "b_ada": nrm(ks[20], (DEPTH, 6 * D_MODEL), 0.02),
        "w_gu": nrm(ks[21], (DEPTH, D_MODEL, 2 * D_FF), D_MODEL ** -0.5),
        "w_down": nrm(ks[22], (DEPTH, D_FF, D_MODEL), D_FF ** -0.5),
        "final_norm": gain(ks[23], (D_MODEL,)),
    }


def reference(x_prompt, x_sample, cache_ckv, cache_krope, state_hgrn, c_prompt, c_sample,
              w_in, q_norm, w_uq, kv_norm, w_ukv, lb_param, hg_norm, w_pa, w_pb, w_out,
              norm1, norm2, w_ada, b_ada, w_gu, w_down, final_norm):
    p = {"w_in": w_in, "q_norm": q_norm, "w_uq": w_uq, "kv_norm": kv_norm, "w_ukv": w_ukv,
         "lb_param": lb_param, "hg_norm": hg_norm, "w_pa": w_pa, "w_pb": w_pb, "w_out": w_out,
         "norm1": norm1, "norm2": norm2, "w_ada": w_ada, "b_ada": b_ada, "w_gu": w_gu,
         "w_down": w_down, "final_norm": final_norm}
    t_prompt = x_prompt.shape[1]
    t_sample = x_sample.shape[1]
    pos_prompt = jnp.arange(t_prompt, dtype=jnp.int32)
    pos_sample = PAST_LEN + jnp.arange(t_sample, dtype=jnp.int32)
    y_prompt, ckv_p, kr_p, s_p = trunk(x_prompt, c_prompt, pos_prompt, p, None, None, None, CHUNK)
    y_sample, ckv_s, kr_s, s_s = trunk(x_sample, c_sample, pos_sample, p, cache_ckv, cache_krope,
                                       state_hgrn, t_sample)
    return (y_prompt, y_sample, ckv_p, kr_p, s_p, ckv_s, kr_s, s_s)
```

```cpp
#include <hip/hip_runtime.h>
#include <hip/hip_cooperative_groups.h>
#include <cstdio>
#include <cstring>
namespace cg = cooperative_groups;

typedef unsigned short u16;
typedef __attribute__((ext_vector_type(8))) short bf16x8;
typedef __attribute__((ext_vector_type(4))) float f32x4;
typedef __attribute__((ext_vector_type(2))) float f32x2;
typedef __attribute__((ext_vector_type(4))) unsigned u32x4;
typedef __attribute__((ext_vector_type(2))) unsigned u32x2;
#define LAS __attribute__((address_space(3)))

#define NTHR 512
#define NP 32768
#define NS 512
#define NT 33280
#define LDZ 4768
#define ZKV 384
#define ZKR 640
#define ZHQ 672
#define ZHF 1184
#define ZHI 1696
#define ZHG 2208
#define ZGA 2720
#define ZGB 3744
#define SKV 2112
#define TSEQ 16384
#define NPHASE 12

#define O_Y 0
#define O_CKVP 34078720
#define O_KRP 42467328
#define O_HSP 43515904
#define O_CKVS 43646976
#define O_KRS 43778048
#define O_HSS 43794432

#define STAGE_BYTES 131072
#define LDS_BYTES (STAGE_BYTES + 256)
#define HG_LDS 44032

struct Params {
  const float *x_prompt, *x_sample, *cache_ckv, *cache_krope, *state_hgrn, *c_prompt, *c_sample;
  const float *w_in, *q_norm, *w_uq, *kv_norm, *w_ukv, *lb_param, *hg_norm, *w_pa, *w_pb, *w_out;
  const float *norm1, *norm2, *w_ada, *b_ada, *w_gu, *w_down, *final_norm;
  float* out;
  u16 *wt_in, *wt_uq, *wt_ukv, *wt_pa, *wt_pb, *wt_out, *wt_gu, *wt_dn;
  float* mod; float* tab;
  u16* H; u16 *KNs, *VTs, *KRs; u16* Z; float* HS; float* DEC;
  u16 *Q, *KNp, *VTp; u16* H1; u16* CKVb;
  unsigned* ctr;
  int p0, p1;
};

__device__ __forceinline__ bf16x8 mk8(unsigned a, unsigned b, unsigned c, unsigned d) { u32x4 t = {a, b, c, d}; return __builtin_bit_cast(bf16x8, t); }
__device__ __forceinline__ bf16x8 cat8(u32x2 lo, u32x2 hi) { u32x4 t = {lo.x, lo.y, hi.x, hi.y}; return __builtin_bit_cast(bf16x8, t); }

typedef __attribute__((ext_vector_type(2))) __bf16 bf16x2_t;
__device__ __forceinline__ unsigned pack2(float a, float b) { const f32x2 v = {a, b}; return __builtin_bit_cast(unsigned, __builtin_convertvector(v, bf16x2_t)); }
__device__ __forceinline__ u16 f2bf(float f) { return (u16)(pack2(f, f) & 0xffffu); }
__device__ __forceinline__ float bf2f(u16 h) { return __uint_as_float(((unsigned)h) << 16); }
__device__ __forceinline__ float bflo(unsigned u) { return __uint_as_float(u << 16); }
__device__ __forceinline__ float bfhi(unsigned u) { return __uint_as_float(u & 0xffff0000u); }
__device__ __forceinline__ float frcp(float x) { return __builtin_amdgcn_rcpf(x); }
__device__ __forceinline__ float sigmoidf_(float x) { return frcp(1.0f + __expf(-x)); }
__device__ __forceinline__ float siluf_(float x) { return x * frcp(1.0f + __expf(-x)); }
__device__ __forceinline__ float wave_sum(float v) {
#pragma unroll
  for (int o = 32; o > 0; o >>= 1) v += __shfl_xor(v, o);
  return v;
}
__device__ __forceinline__ int otid() { int t = threadIdx.x; asm volatile("" : "+v"(t)); return t; }
__device__ __forceinline__ int obid() { int b = blockIdx.x; asm volatile("" : "+s"(b)); return b; }
#define EXP2(x) __builtin_amdgcn_exp2f(x)
__device__ __forceinline__ float max_x32(float x) { const unsigned u = __float_as_uint(x); auto r = __builtin_amdgcn_permlane32_swap(u, u, false, false); return fmaxf(__uint_as_float(r[0]), __uint_as_float(r[1])); }
__device__ __forceinline__ float max_x16(float x) { const unsigned u = __float_as_uint(x); auto r = __builtin_amdgcn_permlane16_swap(u, u, false, false); return fmaxf(__uint_as_float(r[0]), __uint_as_float(r[1])); }
#define MFMA(a, b, c) __builtin_amdgcn_mfma_f32_16x16x32_bf16((a), (b), (c), 0, 0, 0)

#define XB_TMO      128
#define XB_XCNT(j)  (256  + 64 * (j))
#define XB_XSUB(j)  (1280 + 64 * (j))
#define XB_XGEN(j)  (2304 + 64 * (j))
#define XB_TOP      3328
#define XB_TOPGEN   3392
#define XB_SPIN_CAP (1u << 22)
__device__ __forceinline__ unsigned xb_ld(unsigned* p)              { return __hip_atomic_load(p, __ATOMIC_RELAXED, __HIP_MEMORY_SCOPE_AGENT); }
__device__ __forceinline__ unsigned xb_add(unsigned* p, unsigned v) { return __hip_atomic_fetch_add(p, v, __ATOMIC_RELAXED, __HIP_MEMORY_SCOPE_AGENT); }
__device__ __forceinline__ unsigned xb_xcc_id() { return (unsigned)__builtin_amdgcn_s_getreg((3 << 11) | 20) & 0xFu; }
#define XB_SPIN(cond, bar) do { unsigned _sp = 0; while (cond) { __builtin_amdgcn_s_sleep(1); \
    if ((++_sp & 255u) == 0u) { if (xb_ld(&(bar)[XB_TMO])) break; if (_sp > XB_SPIN_CAP) { atomicAdd(&(bar)[XB_TMO], 1u); break; } } } } while (0)
__device__ __forceinline__ void xcd_barrier(unsigned* bar, volatile unsigned* st  ) {
  asm volatile("s_waitcnt vmcnt(0)" ::: "memory");
  __syncthreads();
  if (threadIdx.x == 0) {
    __builtin_amdgcn_s_waitcnt(0);
    const unsigned nloc = st[0], nx = st[1], x = st[2];
    const unsigned old = xb_add(&bar[XB_XSUB(x)], 1u);
    const unsigned gen = old / nloc;
    if (old + 1u == (gen + 1u) * nloc) {
      __builtin_amdgcn_fence(__ATOMIC_RELEASE, "agent");
      asm volatile("s_waitcnt vmcnt(0)" ::: "memory");
      const unsigned og = xb_add(&bar[XB_TOP], 1u);
      const unsigned tg = og / nx;
      if (og + 1u == (tg + 1u) * nx) xb_add(&bar[XB_TOPGEN], 1u);
      else XB_SPIN(xb_ld(&bar[XB_TOPGEN]) == tg, bar);
      __builtin_amdgcn_fence(__ATOMIC_ACQUIRE, "agent");
      xb_add(&bar[XB_XGEN(x)], 1u);
      asm volatile("s_waitcnt vmcnt(0)" ::: "memory");
    } else {
      XB_SPIN(xb_ld(&bar[XB_XGEN(x)]) == gen, bar);
      __builtin_amdgcn_fence(__ATOMIC_ACQUIRE, "agent");
      asm volatile("s_waitcnt vmcnt(0)" ::: "memory");
    }
  }
  __syncthreads();
}

__device__ __forceinline__ int bidx_of(int row) { return row < NP ? (row >> 14) : 2 + ((row - NP) >> 4); }
__device__ __forceinline__ int pos_of(int row) { return row < NP ? (row & (TSEQ - 1)) : 2048 + ((row - NP) & 15); }

__device__ __forceinline__ void transpose_w(const float* __restrict__ src, u16* __restrict__ dst, int K, int N, int mode, float* tile) {
  const int tid = otid();
  const int nkt = K >> 7, nnt = N >> 5, T = nkt * nnt;
  for (int t = obid(); t < T; t += gridDim.x) {
    const int kt = t % nkt, ntile = t / nkt;
    __syncthreads();
#pragma unroll
    for (int ps = 0; ps < 2; ++ps) {
      const int k = (tid >> 3) + 64 * ps, n4 = (tid & 7) * 4;
      const f32x4 v = *(const f32x4*)(src + (size_t)(kt * 128 + k) * N + ntile * 32 + n4);
      tile[k * 33 + n4 + 0] = v.x; tile[k * 33 + n4 + 1] = v.y; tile[k * 33 + n4 + 2] = v.z; tile[k * 33 + n4 + 3] = v.w;
    }
    __syncthreads();
    {
      const int nl = tid >> 4, kc = tid & 15, n = ntile * 32 + nl;
      float f[8];
#pragma unroll
      for (int i = 0; i < 8; ++i) f[i] = tile[(kc * 8 + i) * 33 + nl];
      int R = n;
      if (mode == 1) R = n < 2816 ? ((n >> 4) * 32 + (n & 15)) : (((n - 2816) >> 4) * 32 + 16 + ((n - 2816) & 15));
      u32x4 o = {pack2(f[0], f[1]), pack2(f[2], f[3]), pack2(f[4], f[5]), pack2(f[6], f[7])};
      *(u32x4*)(dst + (size_t)R * K + kt * 128 + kc * 8) = o;
    }
  }
}

__device__ __forceinline__ void adaln(const Params& p, float* sm) {
  const int tid = otid(), lane = tid & 63, w = tid >> 6;
  for (int it = obid(); it < 96; it += gridDim.x) {
    const int col = it * 64 + lane;
    float acc[34];
#pragma unroll
    for (int b = 0; b < 34; ++b) acc[b] = 0.f;
    float* sC = sm + w * (64 * 36);
    for (int kc = 0; kc < 2; ++kc) {
      const int kb = w * 128 + kc * 64;
      __syncthreads();
#pragma unroll
      for (int b = 0; b < 34; ++b) {
        const float* cr = b < 2 ? p.c_prompt + b * 1024 : p.c_sample + (b - 2) * 1024;
        float c = cr[kb + lane];
        sC[lane * 36 + b] = siluf_(c);
      }
      __syncthreads();
#pragma unroll 8
      for (int kk = 0; kk < 64; ++kk) {
        float wv = p.w_ada[(size_t)(kb + kk) * 6144 + col];
#pragma unroll
        for (int b4 = 0; b4 < 8; ++b4) {
          f32x4 s = *(const f32x4*)&sC[kk * 36 + b4 * 4];
          acc[b4 * 4 + 0] += s.x * wv; acc[b4 * 4 + 1] += s.y * wv; acc[b4 * 4 + 2] += s.z * wv; acc[b4 * 4 + 3] += s.w * wv;
        }
        f32x2 s2 = *(const f32x2*)&sC[kk * 36 + 32];
        acc[32] += s2.x * wv; acc[33] += s2.y * wv;
      }
    }
    __syncthreads();
    float* red = sm;
#pragma unroll
    for (int b = 0; b < 34; ++b) red[(w * 34 + b) * 64 + lane] = acc[b];
    __syncthreads();
    for (int idx = tid; idx < 34 * 64; idx += NTHR) {
      int b = idx >> 6, c = idx & 63;
      float s = 0.f;
#pragma unroll
      for (int ww = 0; ww < 8; ++ww) s += red[(ww * 34 + b) * 64 + c];
      p.mod[b * 6144 + it * 64 + c] = s + p.b_ada[it * 64 + c];
    }
    __syncthreads();
  }
}

__device__ __forceinline__ void phase0(const Params& p, unsigned char* smraw) {
  float* smf = (float*)smraw;
  const int tid = otid();
  adaln(p, smf);
  transpose_w(p.w_in, p.wt_in, 1024, 4768, 0, smf);
  transpose_w(p.w_gu, p.wt_gu, 1024, 5632, 1, smf);
  transpose_w(p.w_down, p.wt_dn, 2816, 1024, 0, smf);
  transpose_w(p.w_out, p.wt_out, 1024, 1024, 0, smf);
  transpose_w(p.w_pa, p.wt_pa, 512, 1024, 0, smf);
  transpose_w(p.w_pb, p.wt_pb, 512, 1024, 0, smf);
  transpose_w(p.w_uq, p.wt_uq, 384, 768, 0, smf);
  transpose_w(p.w_ukv, p.wt_ukv, 256, 1024, 0, smf);
  const size_t gt = (size_t)obid() * NTHR + tid, gn = (size_t)gridDim.x * NTHR;
  for (size_t i = gt; i < (size_t)96 * 1024 / 8; i += gn) *(u32x4*)(p.wt_in + (size_t)4768 * 1024 + i * 8) = (u32x4){0u, 0u, 0u, 0u};
  {
    const int nb = (int)gridDim.x, skip = nb > 96 ? 96 : 0;
    if (obid() >= skip) {
      const size_t ct = (size_t)(obid() - skip) * NTHR + tid, cn = (size_t)(nb - skip) * NTHR;
      for (size_t i = ct; i < (size_t)65536 * 256 / 8; i += cn) {
        const f32x4 a = *(const f32x4*)(p.cache_ckv + i * 8), b = *(const f32x4*)(p.cache_ckv + i * 8 + 4);
        u32x4 o = {pack2(a.x, a.y), pack2(a.z, a.w), pack2(b.x, b.y), pack2(b.z, b.w)};
        *(u32x4*)(p.CKVb + i * 8) = o;
      }
    }
  }
  for (size_t i = gt; i < (size_t)TSEQ * 16; i += gn) {
    const int pos = (int)(i >> 4), j = (int)(i & 15);
    const int jm = j & 3, jd = j >> 2;
    double inv = jm == 0 ? 1.0 : (jm == 1 ? 0.5623413251903491 : (jm == 2 ? 0.31622776601683794 : 0.1778279410038923));
    inv *= (jd == 0 ? 1.0 : (jd == 1 ? 0.1 : (jd == 2 ? 0.01 : 0.001)));
    const double a = (double)pos * inv;
    const double k = rint(a * 0.15915494309189535);
    double r = fma(-k, 6.283185307179586, a);
    r = fma(-k, 2.4492935982947064e-16, r);
    const double r2 = r * r;
    double c = 1.0, s = r, tc = 1.0, ts = r;
#pragma unroll 1
    for (int n = 1; n <= 16; ++n) {
      tc *= -r2 / (double)((2 * n - 1) * (2 * n));
      ts *= -r2 / (double)((2 * n) * (2 * n + 1));
      c += tc; s += ts;
    }
    p.tab[pos * 32 + j] = (float)c;
    p.tab[pos * 32 + 16 + j] = (float)s;
  }
  for (size_t i = gt; i < (size_t)32 * SKV * 32; i += gn) {
    int d = (int)(i & 31); size_t r = i >> 5; int s = (int)(r % SKV); int b = (int)(r / SKV);
    if (s < 2048) p.KRs[i] = f2bf(p.cache_krope[((size_t)b * 2048 + s) * 32 + d]);
    else if (s >= 2064) p.KRs[i] = 0;
  }
  for (size_t i = gt; i < (size_t)32 * 48 * 512; i += gn) {
    int c = (int)(i & 511); size_t r = i >> 9; int s = (int)(r % 48); int b = (int)(r / 48);
    p.KNs[((size_t)b * SKV + 2064 + s) * 512 + c] = 0;
  }
  for (size_t i = gt; i < (size_t)32 * 512 * 48; i += gn) {
    int s = (int)(i % 48); size_t r = i / 48;
    p.VTs[r * SKV + 2064 + s] = 0;
  }
}

#define NR 4
__device__ __forceinline__ void norm_mod(const Params& p, int which) {
  const int tid = otid(), lane = tid & 63, w = tid >> 6;
  const float* nwp = which ? p.norm2 : p.norm1;
  u16* dst = which ? p.H : p.H1;
  for (int row0 = (obid() * 8 + w) * NR; row0 < NT; row0 += gridDim.x * 8 * NR) {
    const float* xr = which ? p.out + (size_t)row0 * 1024
                            : (row0 < NP ? p.x_prompt + (size_t)row0 * 1024 : p.x_sample + (size_t)(row0 - NP) * 1024);
    f32x4 v[NR][4]; float ss[NR];
#pragma unroll
    for (int r = 0; r < NR; ++r)
#pragma unroll
      for (int i = 0; i < 4; ++i) v[r][i] = *(const f32x4*)(xr + r * 1024 + i * 256 + lane * 4);
#pragma unroll
    for (int r = 0; r < NR; ++r) {
      ss[r] = 0.f;
#pragma unroll
      for (int i = 0; i < 4; ++i) ss[r] += v[r][i].x * v[r][i].x + v[r][i].y * v[r][i].y + v[r][i].z * v[r][i].z + v[r][i].w * v[r][i].w;
    }
#pragma unroll
    for (int o = 32; o > 0; o >>= 1) {
#pragma unroll
      for (int r = 0; r < NR; ++r) ss[r] += __shfl_xor(ss[r], o);
    }
    const float* md = p.mod + bidx_of(row0) * 6144 + (which ? 3072 : 0);
#pragma unroll
    for (int i = 0; i < 4; ++i) {
      const int col = i * 256 + lane * 4;
      const f32x4 nw = *(const f32x4*)(nwp + col), sh = *(const f32x4*)(md + col), sc = *(const f32x4*)(md + 1024 + col);
#pragma unroll
      for (int r = 0; r < NR; ++r) {
        const float rstd = rsqrtf(ss[r] * (1.0f / 1024.0f) + 1e-6f);
        float h0 = v[r][i].x * rstd * nw.x * (1.f + sc.x) + sh.x;
        float h1 = v[r][i].y * rstd * nw.y * (1.f + sc.y) + sh.y;
        float h2 = v[r][i].z * rstd * nw.z * (1.f + sc.z) + sh.z;
        float h3 = v[r][i].w * rstd * nw.w * (1.f + sc.w) + sh.w;
        u32x2 o; o.x = pack2(h0, h1); o.y = pack2(h2, h3);
        *(u32x2*)(dst + (size_t)(row0 + r) * 1024 + col) = o;
      }
    }
  }
}

__device__ __forceinline__ void final_norm(const Params& p) {
  const int tid = otid(), lane = tid & 63, w = tid >> 6;
  for (int row0 = (obid() * 8 + w) * NR; row0 < NT; row0 += gridDim.x * 8 * NR) {
    float* xr = p.out + (size_t)row0 * 1024;
    f32x4 v[NR][4]; float ss[NR];
#pragma unroll
    for (int r = 0; r < NR; ++r)
#pragma unroll
      for (int i = 0; i < 4; ++i) v[r][i] = *(const f32x4*)(xr + r * 1024 + i * 256 + lane * 4);
#pragma unroll
    for (int r = 0; r < NR; ++r) {
      ss[r] = 0.f;
#pragma unroll
      for (int i = 0; i < 4; ++i) ss[r] += v[r][i].x * v[r][i].x + v[r][i].y * v[r][i].y + v[r][i].z * v[r][i].z + v[r][i].w * v[r][i].w;
    }
#pragma unroll
    for (int o = 32; o > 0; o >>= 1) {
#pragma unroll
      for (int r = 0; r < NR; ++r) ss[r] += __shfl_xor(ss[r], o);
    }
#pragma unroll
    for (int i = 0; i < 4; ++i) {
      const int col = i * 256 + lane * 4;
      const f32x4 nw = *(const f32x4*)(p.final_norm + col);
#pragma unroll
      for (int r = 0; r < NR; ++r) {
        const float rstd = rsqrtf(ss[r] * (1.0f / 1024.0f) + 1e-6f);
        f32x4 o; o.x = v[r][i].x * rstd * nw.x; o.y = v[r][i].y * rstd * nw.y; o.z = v[r][i].z * rstd * nw.z; o.w = v[r][i].w * rstd * nw.w;
        *(f32x4*)(xr + r * 1024 + col) = o;
      }
    }
  }
}

__device__ __forceinline__ void rowpost(const Params& p) {
  const int tid = otid(), lane = tid & 63, w = tid >> 6;
  for (int row0 = (obid() * 8 + w) * 2; row0 < NT; row0 += gridDim.x * 16) {
    u16 rq[2][6], rk[2][4], rx1[2], rx2[2]; float cs[2], sn[2];
#pragma unroll
    for (int r = 0; r < 2; ++r) {
      const u16* z = p.Z + (size_t)(row0 + r) * LDZ;
#pragma unroll
      for (int i = 0; i < 6; ++i) rq[r][i] = z[i * 64 + lane];
#pragma unroll
      for (int i = 0; i < 4; ++i) rk[r][i] = z[ZKV + i * 64 + lane];
      rx1[r] = z[ZKR + (lane & 15)]; rx2[r] = z[ZKR + 16 + (lane & 15)];
      const int pos = pos_of(row0 + r);
      cs[r] = p.tab[pos * 32 + (lane & 15)]; sn[r] = p.tab[pos * 32 + 16 + (lane & 15)];
    }
    float qn[6], kn[4];
#pragma unroll
    for (int i = 0; i < 6; ++i) qn[i] = p.q_norm[i * 64 + lane];
#pragma unroll
    for (int i = 0; i < 4; ++i) kn[i] = p.kv_norm[i * 64 + lane];
#pragma unroll
    for (int r = 0; r < 2; ++r) {
      const int row = row0 + r;
      u16* z = p.Z + (size_t)row * LDZ;
      float q[6], k[4]; float sq = 0.f, sk = 0.f;
#pragma unroll
      for (int i = 0; i < 6; ++i) { q[i] = bf2f(rq[r][i]); sq += q[i] * q[i]; }
#pragma unroll
      for (int i = 0; i < 4; ++i) { k[i] = bf2f(rk[r][i]); sk += k[i] * k[i]; }
#pragma unroll
      for (int o = 32; o > 0; o >>= 1) { sq += __shfl_xor(sq, o); sk += __shfl_xor(sk, o); }
      const float rq_ = rsqrtf(sq * (1.0f / 384.0f) + 1e-6f), rk_ = rsqrtf(sk * (1.0f / 256.0f) + 1e-6f);
#pragma unroll
      for (int i = 0; i < 6; ++i) z[i * 64 + lane] = f2bf(q[i] * rq_ * qn[i]);
      float* o = row < NP ? p.out + O_CKVP + (size_t)row * 256 : p.out + O_CKVS + (size_t)(row - NP) * 256;
#pragma unroll
      for (int i = 0; i < 4; ++i) {
        const float c = k[i] * rk_ * kn[i];
        o[i * 64 + lane] = c;
        z[ZKV + i * 64 + lane] = f2bf(c);
      }
      if (lane < 16) {
        const float x1 = bf2f(rx1[r]), x2 = bf2f(rx2[r]);
        const float o1 = x1 * cs[r] - x2 * sn[r], o2 = x1 * sn[r] + x2 * cs[r];
        if (row < NP) {
          float* ko = p.out + O_KRP + (size_t)row * 32;
          ko[lane] = o1; ko[16 + lane] = o2;
          z[ZKR + lane] = f2bf(o1); z[ZKR + 16 + lane] = f2bf(o2);
        } else {
          float* ko = p.out + O_KRS + (size_t)(row - NP) * 32;
          ko[lane] = o1; ko[16 + lane] = o2;
          const int bs = (row - NP) >> 4, t = (row - NP) & 15;
          u16* kr = p.KRs + ((size_t)bs * SKV + 2048 + t) * 32;
          kr[lane] = f2bf(o1); kr[16 + lane] = f2bf(o2);
        }
      }
    }
  }
}

namespace pg8 {
constexpr int BM = 256, BK = 64, HALF = 128, HTB = HALF * BK * 2, NXCD = 8, WGM = 8;
__device__ __forceinline__ int lds_byte(int r, int c) { const int st = (r >> 4) * 2 + (c >> 5), rr = r & 15, cc = c & 31, ob = rr * 64 + cc * 2; return st * 1024 + (ob ^ (((ob >> 9) & 1) << 5)); }
__device__ __forceinline__ void stage_rc(int b, int& R, int& C) { const int st = b / 1024, sb = b % 1024, swz = sb ^ (((sb >> 9) & 1) << 5); R = (st >> 1) * 16 + swz / 64; C = (st & 1) * 32 + (swz % 64) / 2; }
struct Unit { int pm, pn; };
struct Gemm { const u16* A; int lda; const u16* Bt; int K, nM, nN; };
struct StaticOrder {
  int nM, nN, nwg, G, c;
  __device__ __forceinline__ void init(int nM_, int nN_, int G_, int c_) { nM = nM_; nN = nN_; nwg = nM * nN; G = G_; c = c_; }
  __device__ __forceinline__ bool next(int i, Unit& u) const {
    const long L = (long)i * G + c; if (L >= nwg) return false;
    int wgid = (int)L; { const int q = nwg / NXCD, r = nwg % NXCD, xcd = wgid % NXCD, off = wgid / NXCD; wgid = (xcd < r ? xcd * (q + 1) : r * (q + 1) + (xcd - r) * q) + off; }
    const int nig = WGM * nN, gid = wgid / nig, fm = gid * WGM, gsz = (nM - fm) < WGM ? (nM - fm) : WGM;
    u.pm = fm + ((wgid % nig) % gsz); u.pn = (wgid % nig) / gsz; return true;
  }
};

template <class Epi>
__device__ __forceinline__ void gemm_phase(LAS unsigned char* lds, const Gemm g, const Epi& E) {
  const int tid = otid(), wid = __builtin_amdgcn_readfirstlane(tid >> 6), lane = tid & 63, wr = wid >> 2, wc = wid & 3, fr = lane & 15, fq = lane >> 4;
  int K_ = g.K; asm volatile("" : "+s"(K_));
  const int K = K_, nt = K / BK;
  StaticOrder S; S.init(g.nM, g.nN, (int)gridDim.x, obid());
  unsigned voffA[2], voffB[2];
#pragma unroll
  for (int i = 0; i < 2; ++i) { int R, C; stage_rc(tid * 16 + i * 8192, R, C);
    voffA[i] = (unsigned)(R * g.lda + C) * 2u; voffB[i] = (unsigned)(R * K + C) * 2u; }
  const size_t kstep = (size_t)(BK * 2);
  const size_t hstepA = (size_t)HALF * g.lda * 2, hstepB = (size_t)HALF * K * 2;
  const size_t tstepA = 2 * hstepA, tstepB = 2 * hstepB;
  const unsigned ldsw = (unsigned)wid * 1024u;
  const int aoff = lds_byte(wr * 64 + fr, fq * 8), boff = lds_byte(wc * 32 + fr, fq * 8);
#define PG8_SA(b, h) (((b) * 2 + (h)) * HTB)
#define PG8_SB(b, h) ((4 + (b) * 2 + (h)) * HTB)
#define PG8_STAGE(bufoff, gbase, voff) do { _Pragma("unroll") for (int _i = 0; _i < 2; ++_i) \
        __builtin_amdgcn_global_load_lds((const unsigned*)((const char*)(gbase) + (voff)[_i]), (LAS unsigned*)(lds + (bufoff) + ldsw + _i * 8192), 16, 0, 0); } while (0)
#define PG8_LDA(dst, b, h) do { _Pragma("unroll") for (int m = 0; m < 4; ++m) _Pragma("unroll") for (int k = 0; k < 2; ++k) dst[m][k] = *(const LAS bf16x8*)(lds + PG8_SA(b, h) + aoff + m * 2048 + k * 1024); } while (0)
#define PG8_LDB(dst, b, h) do { _Pragma("unroll") for (int n = 0; n < 2; ++n) _Pragma("unroll") for (int k = 0; k < 2; ++k) dst[n][k] = *(const LAS bf16x8*)(lds + PG8_SB(b, h) + boff + n * 2048 + k * 1024); } while (0)
#define PG8_MMA(ai, bj, At, Bt) do { __builtin_amdgcn_s_setprio(1); _Pragma("unroll") for (int m = 0; m < 4; ++m) _Pragma("unroll") for (int n = 0; n < 2; ++n) _Pragma("unroll") for (int k = 0; k < 2; ++k) \
        acc[ai][bj][m][n] = __builtin_amdgcn_mfma_f32_16x16x32_bf16(Bt[n][k], At[m][k], acc[ai][bj][m][n], 0, 0, 0); __builtin_amdgcn_s_setprio(0); } while (0)
#define PG8_WAIT_V(n) asm volatile("s_waitcnt vmcnt(" #n ")" ::: "memory")
#define PG8_WAIT_L(n) asm volatile("s_waitcnt lgkmcnt(" #n ")" ::: "memory")
#define PG8_BAR __builtin_amdgcn_s_barrier()
#define PG8_SCHED __builtin_amdgcn_sched_barrier(0)
  Unit cur, nxt; int ui = 0;
  if (!S.next(0, cur)) return;
  f32x4 acc[2][2][4][2];
#pragma unroll
  for (int a = 0; a < 2; ++a)
#pragma unroll
    for (int b = 0; b < 2; ++b)
#pragma unroll
      for (int m = 0; m < 4; ++m)
#pragma unroll
        for (int n = 0; n < 2; ++n) acc[a][b][m][n] = (f32x4){0.f, 0.f, 0.f, 0.f};
  bf16x8 At[4][2], B0[2][2], B1[2][2];
  const char* cA = (const char*)g.A + (size_t)cur.pm * tstepA; const char* cB = (const char*)g.Bt + (size_t)cur.pn * tstepB;
  PG8_WAIT_V(0);
  PG8_STAGE(PG8_SB(0, 0), cB, voffB); PG8_STAGE(PG8_SA(0, 0), cA, voffA); PG8_STAGE(PG8_SB(0, 1), cB + hstepB, voffB); PG8_STAGE(PG8_SA(0, 1), cA + hstepA, voffA);
  if (wr == 1) PG8_BAR;
  PG8_WAIT_V(4); PG8_BAR;
  PG8_STAGE(PG8_SB(1, 0), cB + kstep, voffB); PG8_STAGE(PG8_SA(1, 0), cA + kstep, voffA); PG8_STAGE(PG8_SB(1, 1), cB + hstepB + kstep, voffB);
  PG8_WAIT_V(6); PG8_BAR;
  for (;;) {
    const bool has_next = S.next(ui + 1, nxt);
    const char* nA = has_next ? (const char*)g.A + (size_t)nxt.pm * tstepA : cA; const char* nB = has_next ? (const char*)g.Bt + (size_t)nxt.pn * tstepB : cB;
#pragma unroll 1
    for (int t = 0; t < nt; t += 2) {
      const bool last = (t == nt - 2);
      const char* a1 = cA + (size_t)(t + 1) * kstep;
      const char* a2 = last ? nA : cA + (size_t)(t + 2) * kstep; const char* b2 = last ? nB : cB + (size_t)(t + 2) * kstep;
      const char* a3 = a2 + kstep; const char* b3 = b2 + kstep;
      PG8_LDB(B0, 0, 0); PG8_SCHED; PG8_LDA(At, 0, 0); PG8_STAGE(PG8_SA(1, 1), a1 + hstepA, voffA);
      PG8_WAIT_L(8); PG8_BAR; PG8_WAIT_L(0); PG8_MMA(0, 0, At, B0); PG8_BAR; PG8_SCHED;
      PG8_LDB(B1, 0, 1); PG8_STAGE(PG8_SB(0, 0), b2, voffB);
      PG8_BAR; PG8_WAIT_L(0); PG8_MMA(0, 1, At, B1); PG8_BAR;
      PG8_LDA(At, 0, 1); PG8_STAGE(PG8_SA(0, 0), a2, voffA);
      PG8_BAR; PG8_WAIT_L(0); PG8_MMA(1, 0, At, B0); PG8_BAR; PG8_SCHED;
      PG8_STAGE(PG8_SB(0, 1), b2 + hstepB, voffB);
      PG8_WAIT_V(6); PG8_BAR; PG8_MMA(1, 1, At, B1); PG8_BAR;
      PG8_LDB(B0, 1, 0); PG8_SCHED; PG8_LDA(At, 1, 0); PG8_STAGE(PG8_SA(0, 1), a2 + hstepA, voffA);
      PG8_WAIT_L(8); PG8_BAR; PG8_WAIT_L(0); PG8_MMA(0, 0, At, B0); PG8_BAR; PG8_SCHED;
      PG8_LDB(B1, 1, 1); PG8_STAGE(PG8_SB(1, 0), b3, voffB);
      PG8_BAR; PG8_WAIT_L(0); PG8_MMA(0, 1, At, B1); PG8_BAR;
      PG8_LDA(At, 1, 1); PG8_STAGE(PG8_SA(1, 0), a3, voffA);
      PG8_BAR; PG8_WAIT_L(0); PG8_MMA(1, 0, At, B0); PG8_BAR; PG8_SCHED;
      PG8_STAGE(PG8_SB(1, 1), b3 + hstepB, voffB);
      PG8_WAIT_V(6); PG8_BAR; PG8_MMA(1, 1, At, B1); PG8_BAR;
    }
    {
      const int rowb = cur.pm * BM + wr * 64 + fr, colb = cur.pn * BM + wc * 32 + fq * 4;
      const typename Epi::UPre up = E.uload(rowb, colb);
#pragma unroll
      for (int ai = 0; ai < 2; ++ai) {
        typename Epi::Pre pre[4][2];
#pragma unroll
        for (int m = 0; m < 4; ++m)
#pragma unroll
          for (int bj = 0; bj < 2; ++bj) pre[m][bj] = E.load(rowb + ai * HALF + m * 16, colb + bj * HALF);
#pragma unroll
        for (int m = 0; m < 4; ++m)
#pragma unroll
          for (int bj = 0; bj < 2; ++bj) {
            E(rowb + ai * HALF + m * 16, colb + bj * HALF, acc[ai][bj][m][0], acc[ai][bj][m][1], pre[m][bj], up, bj);
            if (Epi::SERIAL) __builtin_amdgcn_sched_barrier(0);
          }
      }
    }
    if (!has_next) break;
#pragma unroll
    for (int a = 0; a < 2; ++a)
#pragma unroll
      for (int b = 0; b < 2; ++b)
#pragma unroll
        for (int m = 0; m < 4; ++m)
#pragma unroll
          for (int n = 0; n < 2; ++n) acc[a][b][m][n] = (f32x4){0.f, 0.f, 0.f, 0.f};
    cur = nxt; cA = nA; cB = nB; ++ui;
  }
  PG8_WAIT_V(0);
  if (wr == 0) PG8_BAR;
  PG8_BAR;
#undef PG8_SA
#undef PG8_SB
#undef PG8_STAGE
#undef PG8_LDA
#undef PG8_LDB
#undef PG8_MMA
#undef PG8_WAIT_V
#undef PG8_WAIT_L
#undef PG8_BAR
#undef PG8_SCHED
}
}

#define BP(T, base, byteoff) ((T*)((char*)(base) + (unsigned)(byteoff)))
#define CBP(T, base, byteoff) ((const T*)((const char*)(base) + (unsigned)(byteoff)))
struct NoPre {};
struct EpiZ {
  static constexpr bool SERIAL = false;
  typedef NoPre Pre; typedef NoPre UPre;
  u16* Z;
  __device__ __forceinline__ UPre uload(int, int) const { return UPre{}; }
  __device__ __forceinline__ Pre load(int, int) const { return Pre{}; }
  __device__ __forceinline__ void operator()(int row, int cb, f32x4 v0, f32x4 v1, const Pre&, const UPre&, int) const {
    const unsigned o = ((unsigned)row * LDZ + cb) * 2u;
    if (cb < LDZ) { u32x2 t; t.x = pack2(v0[0], v0[1]); t.y = pack2(v0[2], v0[3]); *BP(u32x2, Z, o) = t; }
    if (cb + 16 < LDZ) { u32x2 t; t.x = pack2(v1[0], v1[1]); t.y = pack2(v1[2], v1[3]); *BP(u32x2, Z, o + 32u) = t; }
  }
};
struct EpiQ {
  static constexpr bool SERIAL = false;
  struct Pre { f32x4 cs, sn; };
  typedef NoPre UPre;
  u16* Q; const float* tab;
  __device__ __forceinline__ UPre uload(int, int) const { return UPre{}; }
  __device__ __forceinline__ Pre load(int row, int cb) const {
    Pre r; r.cs = (f32x4){1.f, 1.f, 1.f, 1.f}; r.sn = (f32x4){0.f, 0.f, 0.f, 0.f};
    if ((cb & ~15) % 96 == 64) {
      const unsigned to = ((unsigned)pos_of(row) * 32 + (cb & 15)) * 4u;
      r.cs = *CBP(f32x4, tab, to); r.sn = *CBP(f32x4, tab, to + 64u);
    }
    return r;
  }
  __device__ __forceinline__ void operator()(int row, int cb, f32x4 v0, f32x4 v1, const Pre& pr, const UPre&, int) const {
    const float sc = 0.1472444460259031f;
    if ((cb & ~15) % 96 == 64) {
#pragma unroll
      for (int j = 0; j < 4; ++j) {
        float x1 = v0[j], x2 = v1[j];
        v0[j] = x1 * pr.cs[j] - x2 * pr.sn[j];
        v1[j] = x1 * pr.sn[j] + x2 * pr.cs[j];
      }
    }
    u32x2 o0, o1;
    o0.x = pack2(v0[0] * sc, v0[1] * sc); o0.y = pack2(v0[2] * sc, v0[3] * sc);
    o1.x = pack2(v1[0] * sc, v1[1] * sc); o1.y = pack2(v1[2] * sc, v1[3] * sc);
    const unsigned o = ((unsigned)row * 768 + cb) * 2u;
    *BP(u32x2, Q, o) = o0;
    *BP(u32x2, Q, o + 32u) = o1;
  }
};
__device__ __forceinline__ void kv_store(u16* kn, u16* vt, unsigned knrow, unsigned vtbase, unsigned vstride, int cb, f32x4 v0, f32x4 v1) {
  const int hd = cb >> 7, wi = cb & 127;
  if (wi < 64) {
    u32x2 o0, o1;
    o0.x = pack2(v0[0], v0[1]); o0.y = pack2(v0[2], v0[3]); o1.x = pack2(v1[0], v1[1]); o1.y = pack2(v1[2], v1[3]);
    const unsigned o = (knrow * 512 + hd * 64 + wi) * 2u;
    *BP(u32x2, kn, o) = o0;
    *BP(u32x2, kn, o + 32u) = o1;
  } else {
    const unsigned o = (vtbase + (unsigned)(hd * 64 + wi - 64) * vstride) * 2u;
#pragma unroll
    for (int j = 0; j < 4; ++j) {
      *BP(u16, vt, o + (unsigned)j * vstride * 2u) = f2bf(v0[j]);
      *BP(u16, vt, o + (unsigned)(16 + j) * vstride * 2u) = f2bf(v1[j]);
    }
  }
}
template <int MODE>
struct EpiKV {
  static constexpr bool SERIAL = false;
  typedef NoPre Pre; typedef NoPre UPre;
  u16 *KNp, *VTp, *KNs, *VTs;
  __device__ __forceinline__ UPre uload(int, int) const { return UPre{}; }
  __device__ __forceinline__ Pre load(int, int) const { return Pre{}; }
  __device__ __forceinline__ void operator()(int row, int cb, f32x4 v0, f32x4 v1, const Pre&, const UPre&, int) const {
    if (MODE == 0 && row < NP) {
      kv_store(KNp, VTp, (unsigned)row, (unsigned)(row >> 14) * 512u * TSEQ + (unsigned)(row & (TSEQ - 1)), TSEQ, cb, v0, v1);
    } else {
      unsigned bs, sx;
      if (MODE == 0) { bs = (unsigned)(row - NP) >> 4; sx = 2048u + ((unsigned)(row - NP) & 15u); } else { bs = (unsigned)row >> 11; sx = (unsigned)row & 2047u; }
      kv_store(KNs, VTs, bs * SKV + sx, bs * 512u * SKV + sx, SKV, cb, v0, v1);
    }
  }
};
struct EpiMixA {
  static constexpr bool SERIAL = false;
  struct Pre { u32x2 g[2]; };
  typedef NoPre UPre;
  const u16* Z; u16* MX;
  __device__ __forceinline__ UPre uload(int, int) const { return UPre{}; }
  __device__ __forceinline__ Pre load(int row, int cb) const {
    Pre r; const unsigned o = ((unsigned)row * LDZ + ZGA + cb) * 2u;
    r.g[0] = *CBP(u32x2, Z, o); r.g[1] = *CBP(u32x2, Z, o + 32u); return r;
  }
  __device__ __forceinline__ void operator()(int row, int cb, f32x4 v0, f32x4 v1, const Pre& pr, const UPre&, int) const {
    f32x4 v[2] = {v0, v1};
#pragma unroll
    for (int n = 0; n < 2; ++n) {
      const u32x2 g = pr.g[n];
      u32x2 o;
      o.x = pack2(sigmoidf_(bflo(g.x)) * v[n][0], sigmoidf_(bfhi(g.x)) * v[n][1]);
      o.y = pack2(sigmoidf_(bflo(g.y)) * v[n][2], sigmoidf_(bfhi(g.y)) * v[n][3]);
      *BP(u32x2, MX, ((unsigned)row * 1024 + cb + n * 16) * 2u) = o;
    }
  }
};
struct EpiMixB {
  static constexpr bool SERIAL = false;
  struct Pre { u32x2 g[2]; u32x2 a[2]; };
  typedef NoPre UPre;
  const u16* Z; u16* MX;
  __device__ __forceinline__ UPre uload(int, int) const { return UPre{}; }
  __device__ __forceinline__ Pre load(int row, int cb) const {
    Pre r; const unsigned o = ((unsigned)row * LDZ + ZGB + cb) * 2u, m = ((unsigned)row * 1024 + cb) * 2u;
    r.g[0] = *CBP(u32x2, Z, o); r.g[1] = *CBP(u32x2, Z, o + 32u);
    r.a[0] = *CBP(u32x2, MX, m); r.a[1] = *CBP(u32x2, MX, m + 32u); return r;
  }
  __device__ __forceinline__ void operator()(int row, int cb, f32x4 v0, f32x4 v1, const Pre& pr, const UPre&, int) const {
    f32x4 v[2] = {v0, v1};
#pragma unroll
    for (int n = 0; n < 2; ++n) {
      const u32x2 g = pr.g[n], a = pr.a[n];
      u32x2 o;
      o.x = pack2(bflo(a.x) + sigmoidf_(bflo(g.x)) * v[n][0], bfhi(a.x) + sigmoidf_(bfhi(g.x)) * v[n][1]);
      o.y = pack2(bflo(a.y) + sigmoidf_(bflo(g.y)) * v[n][2], bfhi(a.y) + sigmoidf_(bfhi(g.y)) * v[n][3]);
      *BP(u32x2, MX, ((unsigned)row * 1024 + cb + n * 16) * 2u) = o;
    }
  }
};
struct EpiRes1 {
  static constexpr bool SERIAL = false;
  struct Pre { f32x4 x[2]; };
  struct UPre { f32x4 g[2][2]; };
  const float *xp, *xs, *mod; float* XR;
  __device__ __forceinline__ UPre uload(int row, int colb) const {
    UPre u; const unsigned go = ((unsigned)bidx_of(row) * 6144 + 2048 + colb) * 4u;
#pragma unroll
    for (int bj = 0; bj < 2; ++bj)
#pragma unroll
      for (int n = 0; n < 2; ++n) u.g[bj][n] = *CBP(f32x4, mod, go + bj * 512u + n * 64u);
    return u;
  }
  __device__ __forceinline__ Pre load(int row, int cb) const {
    Pre r;
    const float* base = row < NP ? xp : xs;
    const unsigned o = ((unsigned)(row < NP ? row : row - NP) * 1024 + cb) * 4u;
    r.x[0] = *CBP(f32x4, base, o); r.x[1] = *CBP(f32x4, base, o + 64u);
    return r;
  }
  __device__ __forceinline__ void operator()(int row, int cb, f32x4 v0, f32x4 v1, const Pre& pr, const UPre& up, int bj) const {
    f32x4 v[2] = {v0, v1};
#pragma unroll
    for (int n = 0; n < 2; ++n) {
      const f32x4 x = pr.x[n], gg = up.g[bj][n]; f32x4 o;
      o.x = x.x + gg.x * v[n][0]; o.y = x.y + gg.y * v[n][1]; o.z = x.z + gg.z * v[n][2]; o.w = x.w + gg.w * v[n][3];
      *BP(f32x4, XR, ((unsigned)row * 1024 + cb + n * 16) * 4u) = o;
    }
  }
};
struct EpiRes2 {
  static constexpr bool SERIAL = false;
  struct Pre { f32x4 x[2]; };
  struct UPre { f32x4 g[2][2]; };
  const float* mod; float* XR;
  __device__ __forceinline__ UPre uload(int row, int colb) const {
    UPre u; const unsigned go = ((unsigned)bidx_of(row) * 6144 + 5120 + colb) * 4u;
#pragma unroll
    for (int bj = 0; bj < 2; ++bj)
#pragma unroll
      for (int n = 0; n < 2; ++n) u.g[bj][n] = *CBP(f32x4, mod, go + bj * 512u + n * 64u);
    return u;
  }
  __device__ __forceinline__ Pre load(int row, int cb) const {
    Pre r; const unsigned o = ((unsigned)row * 1024 + cb) * 4u;
    r.x[0] = *CBP(f32x4, XR, o); r.x[1] = *CBP(f32x4, XR, o + 64u); return r;
  }
  __device__ __forceinline__ void operator()(int row, int cb, f32x4 v0, f32x4 v1, const Pre& pr, const UPre& up, int bj) const {
    f32x4 v[2] = {v0, v1};
#pragma unroll
    for (int n = 0; n < 2; ++n) {
      const f32x4 x = pr.x[n], gg = up.g[bj][n]; f32x4 o;
      o.x = x.x + gg.x * v[n][0]; o.y = x.y + gg.y * v[n][1]; o.z = x.z + gg.z * v[n][2]; o.w = x.w + gg.w * v[n][3];
      *BP(f32x4, XR, ((unsigned)row * 1024 + cb + n * 16) * 4u) = o;
    }
  }
};
struct EpiSwiglu {
  static constexpr bool SERIAL = false;
  typedef NoPre Pre; typedef NoPre UPre;
  u16* ACT;
  __device__ __forceinline__ UPre uload(int, int) const { return UPre{}; }
  __device__ __forceinline__ Pre load(int, int) const { return Pre{}; }
  __device__ __forceinline__ void operator()(int row, int cb, f32x4 v0, f32x4 v1, const Pre&, const UPre&, int) const {
    const int acol = ((cb & ~15) >> 5) * 16 + (cb & 15);
    float r[4];
#pragma unroll
    for (int j = 0; j < 4; ++j) { r[j] = siluf_(v0[j]) * v1[j]; }
    u32x2 o; o.x = pack2(r[0], r[1]); o.y = pack2(r[2], r[3]);
    *BP(u32x2, ACT, ((unsigned)row * 2816 + acol) * 2u) = o;
  }
};

template <class Epi>
__device__ __forceinline__ void sgemm_rows(const u16* __restrict__ A, int lda, const u16* __restrict__ Bt, int K, int N, const Epi& E, float* sred) {
  const int tid = otid(), lane = tid & 63, w = tid >> 6, lr = lane & 15, lg = lane >> 4;
  const int quad = w >> 2, kq = w & 3;
  const int ntr = NS >> 4, T = (N >> 5) * ntr, KL = K >> 2;
  for (int base = obid() * 2; base < T; base += gridDim.x * 2) {
    const int t = base + quad;
    const bool valid = t < T;
    const int tr = t % ntr, tc = t / ntr;
    const int erow = NP + tr * 16 + lr, ecb = tc * 32 + lg * 4;
    f32x4 c0 = {0.f, 0.f, 0.f, 0.f}, c1 = {0.f, 0.f, 0.f, 0.f};
    typename Epi::UPre up; typename Epi::Pre pre;
    if (valid && kq == 0) { up = E.uload(erow, ecb); pre = E.load(erow, ecb); }
    if (valid) {
      const u16* a = A + (size_t)(NP + tr * 16 + lr) * lda + kq * KL + lg * 8;
      const u16* b0 = Bt + (size_t)(tc * 32 + lr) * K + kq * KL + lg * 8;
      const u16* b1 = b0 + (size_t)16 * K;
#pragma unroll 4
      for (int k = 0; k < KL; k += 64) {
        bf16x8 fa[2], fb0[2], fb1[2];
#pragma unroll
        for (int i = 0; i < 2; ++i) { fa[i] = *(const bf16x8*)(a + k + i * 32); fb0[i] = *(const bf16x8*)(b0 + k + i * 32); fb1[i] = *(const bf16x8*)(b1 + k + i * 32); }
#pragma unroll
        for (int i = 0; i < 2; ++i) { c0 = MFMA(fb0[i], fa[i], c0); c1 = MFMA(fb1[i], fa[i], c1); }
      }
    }
    __syncthreads();
    if (kq != 0) {
      float* r = sred + ((quad * 3 + (kq - 1)) * 8) * 64 + lane;
#pragma unroll
      for (int j = 0; j < 4; ++j) { r[j * 64] = c0[j]; r[(4 + j) * 64] = c1[j]; }
    }
    __syncthreads();
    if (kq == 0 && valid) {
#pragma unroll
      for (int q = 0; q < 3; ++q) {
        const float* r = sred + ((quad * 3 + q) * 8) * 64 + lane;
#pragma unroll
        for (int j = 0; j < 4; ++j) { c0[j] += r[j * 64]; c1[j] += r[(4 + j) * 64]; }
      }
      E(erow, ecb, c0, c1, pre, up, 0);
    }
  }
}

template <bool outmode>
__device__ __forceinline__ void hgrn_run(const Params& p, int pairitem, unsigned char* smraw0) {
  const int tidf = otid();
  const int half = tidf >> 8;
  unsigned char* smraw = smraw0 + half * HG_LDS;
  const int item = pairitem * 2 + half;
  u16* sQ = (u16*)smraw;
  u16* sK = sQ + 32 * 136;
  u16* sKT = sK + 32 * 136;
  u16* sVT = sKT + 128 * 40;
  u16* sAtt = sVT + 128 * 40;
  float* sDec = (float*)(sAtt + 32 * 40);
  float* sSq = sDec + 128;
  const int tid = tidf & 255, lane = tid & 63, w = tid >> 6, lr = lane & 15, lg = lane >> 4;
  int h, tok0, nblk, nv; size_t hsbase = 0; const float* s0 = nullptr; float* sout = nullptr; int decidx = 0;
  if (item < 512) {
    const int bh = item >> 6, r = item & 63;
    h = bh & 3; tok0 = (bh >> 2) * TSEQ + r * 256; nblk = 8; nv = 32;
    hsbase = (size_t)item << 14; decidx = item * 128;
    if (outmode) s0 = p.HS + hsbase;
  } else {
    const int si = item - 512, bs = si >> 2;
    h = si & 3; tok0 = NP + bs * 16; nblk = 1; nv = 16;
    s0 = p.state_hgrn + ((size_t)si << 14);
    sout = p.out + O_HSS + ((size_t)si << 14);
  }
  f32x4 accS[8][2];
#pragma unroll
  for (int mt = 0; mt < 8; ++mt)
#pragma unroll
    for (int nt = 0; nt < 2; ++nt) {
      if (s0) {
#pragma unroll
        for (int j = 0; j < 4; ++j) accS[mt][nt][j] = s0[(mt * 16 + lg * 4 + j) * 128 + w * 32 + nt * 16 + lr];
      } else accS[mt][nt] = (f32x4){0.f, 0.f, 0.f, 0.f};
    }
  float* sP = sSq + 128;
  const int cp = tid & 63, tg = tid >> 6;
  const float lb0 = sigmoidf_(p.lb_param[h * 128 + 2 * cp] - p.lb_param[512 + h * 128 + 2 * cp]);
  const float lb1 = sigmoidf_(p.lb_param[h * 128 + 2 * cp + 1] - p.lb_param[512 + h * 128 + 2 * cp + 1]);
  const float om0 = 1.0f - lb0, om1 = 1.0f - lb1;
  float dtot0 = 1.f, dtot1 = 1.f;
  const float hgscale = 0.08838834764831845f;
  unsigned rf[8], rq[8], rv[8];
#define HG_LOAD(BLK)                                                                                           \
  {                                                                                                            \
    const u16* zb_ = p.Z + (size_t)(tok0 + (BLK) * 32 + tg * 8) * LDZ + h * 128 + 2 * cp;                      \
    _Pragma("unroll") for (int i = 0; i < 8; ++i) {                                                            \
      if (tg * 8 + i < nv) {                                                                                   \
        const u16* z = zb_ + (size_t)i * LDZ;                                                                  \
        rf[i] = *(const unsigned*)(z + ZHF); rv[i] = *(const unsigned*)(z + ZHI);                              \
        rq[i] = outmode ? *(const unsigned*)(z + ZHQ) : 0u;                                                    \
      } else { rf[i] = 0u; rv[i] = 0u; rq[i] = 0u; }                                                           \
    }                                                                                                          \
  }
  HG_LOAD(0)

#pragma unroll 1
  for (int blk = 0; blk < nblk; ++blk) {
    const int tb = tok0 + blk * 32;
    {
      float eb0 = 1.f, eb1 = 1.f;
      float q0[8], q1[8], k0[8], k1[8];
#pragma unroll
      for (int i = 0; i < 8; ++i) {
        q0[i] = 0.f; q1[i] = 0.f; k0[i] = 0.f; k1[i] = 0.f;
        if (tg * 8 + i < nv) {
          const float e0 = __expf(-bflo(rf[i])), e1 = __expf(-bfhi(rf[i]));
          const float s0_ = frcp(1.0f + e0), s1_ = frcp(1.0f + e1);
          eb0 *= lb0 + om0 * s0_; eb1 *= lb1 + om1 * s1_;
          k0[i] = om0 * e0 * s0_ * frcp(eb0); k1[i] = om1 * e1 * s1_ * frcp(eb1);
          if (outmode) { q0[i] = siluf_(bflo(rq[i])) * hgscale * eb0; q1[i] = siluf_(bfhi(rq[i])) * hgscale * eb1; }
        }
      }
      sP[tg * 128 + 2 * cp] = eb0; sP[tg * 128 + 2 * cp + 1] = eb1;
      __syncthreads();
      float pre0 = 1.f, pre1 = 1.f;
#pragma unroll
      for (int g = 0; g < 3; ++g) if (g < tg) { pre0 *= sP[g * 128 + 2 * cp]; pre1 *= sP[g * 128 + 2 * cp + 1]; }
      if (tg == 3) { const float d0 = pre0 * eb0, d1 = pre1 * eb1; sDec[2 * cp] = d0; sDec[2 * cp + 1] = d1; dtot0 *= d0; dtot1 *= d1; }
      const float in0 = frcp(pre0), in1 = frcp(pre1);
#pragma unroll
      for (int i = 0; i < 8; ++i) {
        k0[i] *= in0; k1[i] *= in1;
        if (outmode) {
          const int t = tg * 8 + i;
          *(unsigned*)&sQ[t * 136 + 2 * cp] = pack2(q0[i] * pre0, q1[i] * pre1);
          *(unsigned*)&sK[t * 136 + 2 * cp] = pack2(k0[i], k1[i]);
        }
      }
      { u32x4 a = {pack2(k0[0], k0[1]), pack2(k0[2], k0[3]), pack2(k0[4], k0[5]), pack2(k0[6], k0[7])};
        u32x4 c = {pack2(k1[0], k1[1]), pack2(k1[2], k1[3]), pack2(k1[4], k1[5]), pack2(k1[6], k1[7])};
        *(u32x4*)&sKT[(2 * cp) * 40 + tg * 8] = a; *(u32x4*)&sKT[(2 * cp + 1) * 40 + tg * 8] = c; }
      { u32x4 a, c;
        a.x = (rv[0] & 0xffffu) | (rv[1] << 16); a.y = (rv[2] & 0xffffu) | (rv[3] << 16);
        a.z = (rv[4] & 0xffffu) | (rv[5] << 16); a.w = (rv[6] & 0xffffu) | (rv[7] << 16);
        c.x = (rv[0] >> 16) | (rv[1] & 0xffff0000u); c.y = (rv[2] >> 16) | (rv[3] & 0xffff0000u);
        c.z = (rv[4] >> 16) | (rv[5] & 0xffff0000u); c.w = (rv[6] >> 16) | (rv[7] & 0xffff0000u);
        *(u32x4*)&sVT[(2 * cp) * 40 + tg * 8] = a; *(u32x4*)&sVT[(2 * cp + 1) * 40 + tg * 8] = c; }
    }
    __syncthreads();
    if (blk + 1 < nblk) HG_LOAD(blk + 1)
    f32x4 ot[2][2];
    if (outmode) {
      {
        const int si = w & 1, ti = w >> 1;
        f32x4 at = (f32x4){0.f, 0.f, 0.f, 0.f};
#pragma unroll
        for (int ks = 0; ks < 4; ++ks) {
          bf16x8 a = *(const bf16x8*)&sK[(si * 16 + lr) * 136 + ks * 32 + lg * 8];
          bf16x8 b = *(const bf16x8*)&sQ[(ti * 16 + lr) * 136 + ks * 32 + lg * 8];
          at = MFMA(a, b, at);
        }
        const int t = ti * 16 + lr, sb = si * 16 + lg * 4;
        float m0 = (sb + 0 <= t) ? at[0] : 0.f, m1 = (sb + 1 <= t) ? at[1] : 0.f, m2 = (sb + 2 <= t) ? at[2] : 0.f, m3 = (sb + 3 <= t) ? at[3] : 0.f;
        u32x2 o; o.x = pack2(m0, m1); o.y = pack2(m2, m3);
        *(u32x2*)&sAtt[t * 40 + sb] = o;
      }
      __syncthreads();
#pragma unroll
      for (int vt = 0; vt < 2; ++vt)
#pragma unroll
        for (int tt = 0; tt < 2; ++tt) ot[vt][tt] = (f32x4){0.f, 0.f, 0.f, 0.f};
      {
        bf16x8 bq[2];
#pragma unroll
        for (int tt = 0; tt < 2; ++tt) bq[tt] = *(const bf16x8*)&sAtt[(tt * 16 + lr) * 40 + lg * 8];
#pragma unroll
        for (int vt = 0; vt < 2; ++vt) {
          bf16x8 a = *(const bf16x8*)&sVT[(w * 32 + vt * 16 + lr) * 40 + lg * 8];
#pragma unroll
          for (int tt = 0; tt < 2; ++tt) ot[vt][tt] = MFMA(a, bq[tt], ot[vt][tt]);
        }
      }
#pragma unroll
      for (int kk = 0; kk < 4; ++kk) {
        bf16x8 bq[2];
#pragma unroll
        for (int tt = 0; tt < 2; ++tt)
          bq[tt] = cat8(*(const u32x2*)&sQ[(tt * 16 + lr) * 136 + (2 * kk) * 16 + lg * 4],
                        *(const u32x2*)&sQ[(tt * 16 + lr) * 136 + (2 * kk + 1) * 16 + lg * 4]);
#pragma unroll
        for (int vt = 0; vt < 2; ++vt) {
          bf16x8 a = mk8(pack2(accS[2 * kk][vt][0], accS[2 * kk][vt][1]), pack2(accS[2 * kk][vt][2], accS[2 * kk][vt][3]),
                         pack2(accS[2 * kk + 1][vt][0], accS[2 * kk + 1][vt][1]), pack2(accS[2 * kk + 1][vt][2], accS[2 * kk + 1][vt][3]));
#pragma unroll
          for (int tt = 0; tt < 2; ++tt) ot[vt][tt] = MFMA(a, bq[tt], ot[vt][tt]);
        }
      }
    }
    {
      bf16x8 bv[2];
#pragma unroll
      for (int nt = 0; nt < 2; ++nt) bv[nt] = *(const bf16x8*)&sVT[(w * 32 + nt * 16 + lr) * 40 + lg * 8];
#pragma unroll
      for (int mt = 0; mt < 8; ++mt) {
        bf16x8 a = *(const bf16x8*)&sKT[(mt * 16 + lr) * 40 + lg * 8];
        f32x4 dc = *(const f32x4*)&sDec[mt * 16 + lg * 4];
#pragma unroll
        for (int nt = 0; nt < 2; ++nt) {
          f32x4 r = MFMA(a, bv[nt], accS[mt][nt]);
          r[0] *= dc.x; r[1] *= dc.y; r[2] *= dc.z; r[3] *= dc.w;
          accS[mt][nt] = r;
        }
      }
    }
    if (outmode) {
#pragma unroll
      for (int tt = 0; tt < 2; ++tt) {
        float ss = 0.f;
#pragma unroll
        for (int vt = 0; vt < 2; ++vt)
#pragma unroll
          for (int j = 0; j < 4; ++j) ss += ot[vt][tt][j] * ot[vt][tt][j];
        ss += __shfl_xor(ss, 16); ss += __shfl_xor(ss, 32);
        if (lg == 0) sSq[w * 32 + tt * 16 + lr] = ss;
      }
      __syncthreads();
#pragma unroll
      for (int tt = 0; tt < 2; ++tt) {
        const int t = tt * 16 + lr;
        const float tot = sSq[t] + sSq[32 + t] + sSq[64 + t] + sSq[96 + t];
        const float rstd = rsqrtf(tot * (1.0f / 128.0f) + 1e-6f);
        if (t < nv) {
          u16* z = p.Z + (size_t)(tb + t) * LDZ + h * 128;
#pragma unroll
          for (int vt = 0; vt < 2; ++vt) {
            const int vch = w * 32 + vt * 16 + lg * 4;
            u32x2 g = *(const u32x2*)(z + ZHG + vch);
            f32x4 nw = *(const f32x4*)(p.hg_norm + vch);
            float g0 = bflo(g.x), g1 = bfhi(g.x), g2 = bflo(g.y), g3 = bfhi(g.y);
            float r0 = ot[vt][tt][0] * rstd * nw.x * siluf_(g0);
            float r1 = ot[vt][tt][1] * rstd * nw.y * siluf_(g1);
            float r2 = ot[vt][tt][2] * rstd * nw.z * siluf_(g2);
            float r3 = ot[vt][tt][3] * rstd * nw.w * siluf_(g3);
            u32x2 o; o.x = pack2(r0, r1); o.y = pack2(r2, r3);
            *(u32x2*)(z + ZHQ + vch) = o;
          }
        }
      }
    }
    __syncthreads();
  }
  if (!outmode) {
#pragma unroll
    for (int mt = 0; mt < 8; ++mt)
#pragma unroll
      for (int nt = 0; nt < 2; ++nt)
#pragma unroll
        for (int j = 0; j < 4; ++j) p.HS[hsbase + (mt * 16 + lg * 4 + j) * 128 + w * 32 + nt * 16 + lr] = accS[mt][nt][j];
    if (tg == 3) { p.DEC[decidx + 2 * cp] = dtot0; p.DEC[decidx + 2 * cp + 1] = dtot1; }
  } else if (sout) {
#pragma unroll
    for (int mt = 0; mt < 8; ++mt)
#pragma unroll
      for (int nt = 0; nt < 2; ++nt)
#pragma unroll
        for (int j = 0; j < 4; ++j) sout[(mt * 16 + lg * 4 + j) * 128 + w * 32 + nt * 16 + lr] = accS[mt][nt][j];
  }
}

__device__ __forceinline__ void hgrn_scan(const Params& p, int it) {
  const int e = it * NTHR + otid();
  const int bh = e >> 14, rem = e & 16383, kch = rem >> 7;
  float S = 0.f;
#pragma unroll 1
  for (int r0 = 0; r0 < 64; r0 += 16) {
    float L[16], d[16];
#pragma unroll
    for (int i = 0; i < 16; ++i) {
      L[i] = p.HS[((size_t)(bh * 64 + r0 + i) << 14) + rem];
      d[i] = p.DEC[(bh * 64 + r0 + i) * 128 + kch];
    }
#pragma unroll
    for (int i = 0; i < 16; ++i) {
      p.HS[((size_t)(bh * 64 + r0 + i) << 14) + rem] = S;
      S = d[i] * S + L[i];
    }
  }
  p.out[O_HSP + e] = S;
}

typedef __attribute__((ext_vector_type(16))) float f32x16;
#define MFMA32(a, b, c) __builtin_amdgcn_mfma_f32_32x32x16_bf16((a), (b), (c), 0, 0, 0)
__device__ __forceinline__ void attn_prompt(const Params& p, int item, unsigned char* smraw) {
  u16* sb0 = (u16*)smraw;
  const int tid = otid(), lane = tid & 63, w = tid >> 6, lq = lane & 31, hh = lane >> 5;
  const int qb = 63 - (item >> 4), bh = item & 15, b = bh >> 3, h = bh & 7;
  const int ntr = 2 * qb + 2;
  const int nvis = 4 * qb + (w >> 1) + 1;
  const int q0 = b * TSEQ + qb * 256 + w * 32;
  bf16x8 qf[6];
#pragma unroll
  for (int ks = 0; ks < 6; ++ks) qf[ks] = *(const bf16x8*)(p.Q + (size_t)(q0 + lq) * 768 + h * 96 + ks * 16 + hh * 8);
  f32x16 ot[2];
#pragma unroll
  for (int dt = 0; dt < 2; ++dt)
#pragma unroll
    for (int r = 0; r < 16; ++r) ot[dt][r] = 0.f;
  float nm = 0.f, lrun = 0.f;
  bool first = true;
  u32x4 rk[2], rr, rv[2];
#define ATT_BUF_U16 22016
#define ATT_LOAD(TR)                                                                                          \
  {                                                                                                           \
    const int kb_ = b * TSEQ + (TR) * 128;                                                                    \
    _Pragma("unroll") for (int i = 0; i < 2; ++i) {                                                           \
      const int c_ = tid + i * 512;                                                                           \
      rk[i] = *(const u32x4*)(p.KNp + (size_t)(kb_ + (c_ >> 3)) * 512 + h * 64 + (c_ & 7) * 8);              \
      rv[i] = *(const u32x4*)(p.VTp + ((size_t)(b * 512 + h * 64 + (c_ >> 4))) * TSEQ + (TR) * 128 + (c_ & 15) * 8); \
    }                                                                                                         \
    rr = *(const u32x4*)(p.Z + (size_t)(kb_ + (tid >> 2)) * LDZ + ZKR + (tid & 3) * 8);                       \
  }
#define ATT_WRITE(BI)                                                                                         \
  {                                                                                                           \
    u16* k_ = sb0 + (BI) * ATT_BUF_U16; u16* v_ = k_ + 128 * 104;                                             \
    _Pragma("unroll") for (int i = 0; i < 2; ++i) {                                                           \
      const int c_ = tid + i * 512;                                                                           \
      *(u32x4*)&k_[(c_ >> 3) * 104 + (c_ & 7) * 8] = rk[i];                                                   \
      u16* vd_ = &v_[(c_ >> 4) * 136 + ((c_ & 15) >> 1) * 16 + (c_ & 1) * 4];     \
      *(u32x2*)vd_ = (u32x2){rv[i].x, rv[i].y}; *(u32x2*)(vd_ + 8) = (u32x2){rv[i].z, rv[i].w};               \
    }                                                                                                         \
    *(u32x4*)&k_[(tid >> 2) * 104 + 64 + (tid & 3) * 8] = rr;                                                 \
  }
  ATT_LOAD(0)
  ATT_WRITE(0)
  ATT_LOAD(1)
  __syncthreads();
#pragma unroll 1
  for (int tr = 0; tr < ntr; ++tr) {
    if (tr + 1 < ntr) ATT_WRITE((tr + 1) & 1)
    if (tr + 2 < ntr) ATT_LOAD(tr + 2)
    const u16* sK = sb0 + (tr & 1) * ATT_BUF_U16;
    const u16* sVT = sK + 128 * 104;
    if (2 * tr >= nvis) { __syncthreads(); continue; }
    const bool halfvis = (2 * tr + 1 >= nvis);
    f32x16 st[4];
    f32x16 nmv;
#pragma unroll
    for (int r = 0; r < 16; ++r) nmv[r] = nm;
    __builtin_amdgcn_s_setprio(1);
#pragma unroll
    for (int kt = 0; kt < 4; ++kt) {
      const bf16x8 kf = *(const bf16x8*)&sK[(kt * 32 + lq) * 104 + hh * 8];
      st[kt] = MFMA32(kf, qf[0], nmv);
    }
#pragma unroll
    for (int ks = 1; ks < 6; ++ks)
#pragma unroll
      for (int kt = 0; kt < 4; ++kt) {
        const bf16x8 kf = *(const bf16x8*)&sK[(kt * 32 + lq) * 104 + ks * 16 + hh * 8];
        st[kt] = MFMA32(kf, qf[ks], st[kt]);
      }
    __builtin_amdgcn_s_setprio(0);
    if (__any(halfvis)) {
#pragma unroll
      for (int kt = 2; kt < 4; ++kt)
#pragma unroll
        for (int r = 0; r < 16; ++r) st[kt][r] = -INFINITY;
    }
    {
      float mx = fmaxf(fmaxf(st[0][0], st[0][1]), st[0][2]);
#pragma unroll
      for (int r = 3; r < 16; r += 2) mx = fmaxf(fmaxf(mx, st[0][r]), st[0][r + 1 < 16 ? r + 1 : r]);
#pragma unroll
      for (int kt = 1; kt < 4; ++kt)
#pragma unroll
        for (int r = 0; r < 16; r += 2) mx = fmaxf(fmaxf(mx, st[kt][r]), st[kt][r + 1]);
      mx = max_x32(mx);
      if (first || __any(mx > 8.0f)) {
        const float delta = first ? mx : fmaxf(mx, 0.f);
#pragma unroll
        for (int kt = 0; kt < 4; ++kt)
#pragma unroll
          for (int r = 0; r < 16; ++r) st[kt][r] -= delta;
        nm -= delta;
        if (!first) {
          const float alpha = EXP2(-delta);
          lrun *= alpha;
#pragma unroll
          for (int dt = 0; dt < 2; ++dt)
#pragma unroll
            for (int r = 0; r < 16; ++r) ot[dt][r] *= alpha;
        }
      }
      float ps0 = 0.f, ps1 = 0.f;
#pragma unroll
      for (int kt = 0; kt < 4; ++kt)
#pragma unroll
        for (int r = 0; r < 16; r += 2) {
          const float e0 = EXP2(st[kt][r]), e1 = EXP2(st[kt][r + 1]);
          st[kt][r] = e0; st[kt][r + 1] = e1;
          ps0 += e0; ps1 += e1;
        }
      lrun += ps0 + ps1;
    }
    first = false;
#pragma unroll
    for (int kt = 0; kt < 4; ++kt)
#pragma unroll
      for (int s2 = 0; s2 < 2; ++s2) {
        const bf16x8 pb = mk8(pack2(st[kt][8 * s2 + 0], st[kt][8 * s2 + 1]), pack2(st[kt][8 * s2 + 2], st[kt][8 * s2 + 3]),
                              pack2(st[kt][8 * s2 + 4], st[kt][8 * s2 + 5]), pack2(st[kt][8 * s2 + 6], st[kt][8 * s2 + 7]));
#pragma unroll
        for (int dt = 0; dt < 2; ++dt) {
          const bf16x8 a = *(const bf16x8*)&sVT[(dt * 32 + lq) * 136 + kt * 32 + 16 * s2 + 8 * hh];
          ot[dt] = MFMA32(a, pb, ot[dt]);
        }
      }
    __syncthreads();
  }
#undef ATT_WRITE
#undef ATT_LOAD
  {
    float l = lrun;
    l += __shfl_xor(l, 32);
    const float inv = 1.0f / l;
    u16* o = p.Z + (size_t)(q0 + lq) * LDZ + h * 64;
#pragma unroll
    for (int dt = 0; dt < 2; ++dt)
#pragma unroll
      for (int rg = 0; rg < 4; ++rg) {
        u32x2 v; v.x = pack2(ot[dt][4 * rg + 0] * inv, ot[dt][4 * rg + 1] * inv); v.y = pack2(ot[dt][4 * rg + 2] * inv, ot[dt][4 * rg + 3] * inv);
        *(u32x2*)(o + dt * 32 + 8 * rg + 4 * hh) = v;
      }
  }
}

__device__ __forceinline__ void attn_sample(const Params& p, int item, unsigned char* smraw) {
  float* sM = (float*)smraw;
  float* sL = sM + 512;
  float* sO = sL + 512;
  const int tid = otid(), lane = tid & 63, w = tid >> 6, lr = lane & 15, lg = lane >> 4;
  const int bs = item >> 3, h = item & 7;
  bf16x8 qf[3];
#pragma unroll
  for (int ks = 0; ks < 3; ++ks) qf[ks] = *(const bf16x8*)(p.Q + (size_t)(NP + bs * 16 + lr) * 768 + h * 96 + ks * 32 + lg * 8);
  f32x4 ot[4];
#pragma unroll
  for (int dt = 0; dt < 4; ++dt) ot[dt] = (f32x4){0.f, 0.f, 0.f, 0.f};
  float mrun = -INFINITY, lrun = 0.f;
  for (int kt = w; kt < 33; kt += 8) {
    const size_t kb = (size_t)bs * SKV + kt * 64;
    f32x4 st[4];
#pragma unroll
    for (int a = 0; a < 4; ++a) st[a] = (f32x4){0.f, 0.f, 0.f, 0.f};
#pragma unroll
    for (int a = 0; a < 4; ++a) {
      const size_t krow = kb + a * 16 + lr;
      bf16x8 k0 = *(const bf16x8*)(p.KNs + krow * 512 + h * 64 + lg * 8);
      bf16x8 k1 = *(const bf16x8*)(p.KNs + krow * 512 + h * 64 + 32 + lg * 8);
      bf16x8 k2 = *(const bf16x8*)(p.KRs + krow * 32 + lg * 8);
      st[a] = MFMA(k0, qf[0], st[a]); st[a] = MFMA(k1, qf[1], st[a]); st[a] = MFMA(k2, qf[2], st[a]);
    }
    if (kt == 32) {
#pragma unroll
      for (int a = 1; a < 4; ++a) st[a] = (f32x4){-INFINITY, -INFINITY, -INFINITY, -INFINITY};
    }
    float mx = st[0][0];
#pragma unroll
    for (int a = 0; a < 4; ++a)
#pragma unroll
      for (int j = 0; j < 4; ++j) mx = fmaxf(mx, st[a][j]);
    mx = fmaxf(mx, __shfl_xor(mx, 16)); mx = fmaxf(mx, __shfl_xor(mx, 32));
    const float mnew = fmaxf(mrun, mx);
    const float alpha = EXP2(mrun - mnew);
    mrun = mnew;
    float ps = 0.f;
#pragma unroll
    for (int a = 0; a < 4; ++a)
#pragma unroll
      for (int j = 0; j < 4; ++j) { float e = EXP2(st[a][j] - mnew); st[a][j] = e; ps += e; }
    lrun = lrun * alpha + ps;
#pragma unroll
    for (int dt = 0; dt < 4; ++dt) { ot[dt][0] *= alpha; ot[dt][1] *= alpha; ot[dt][2] *= alpha; ot[dt][3] *= alpha; }
#pragma unroll
    for (int s = 0; s < 2; ++s) {
      bf16x8 pb = mk8(pack2(st[2 * s][0], st[2 * s][1]), pack2(st[2 * s][2], st[2 * s][3]),
                      pack2(st[2 * s + 1][0], st[2 * s + 1][1]), pack2(st[2 * s + 1][2], st[2 * s + 1][3]));
#pragma unroll
      for (int dt = 0; dt < 4; ++dt) {
        const u16* vr = p.VTs + ((size_t)bs * 512 + h * 64 + dt * 16 + lr) * SKV + kt * 64;
        bf16x8 a = cat8(*(const u32x2*)(vr + (2 * s) * 16 + lg * 4), *(const u32x2*)(vr + (2 * s + 1) * 16 + lg * 4));
        ot[dt] = MFMA(a, pb, ot[dt]);
      }
    }
  }
  lrun += __shfl_xor(lrun, 16); lrun += __shfl_xor(lrun, 32);
  __syncthreads();
  sM[w * 64 + lane] = mrun; sL[w * 64 + lane] = lrun;
#pragma unroll
  for (int dt = 0; dt < 4; ++dt)
#pragma unroll
    for (int j = 0; j < 4; ++j) sO[(w * 16 + dt * 4 + j) * 64 + lane] = ot[dt][j];
  __syncthreads();
  if (w < 4) {
    const int dt = w;
    float mm[8], M = -INFINITY;
#pragma unroll
    for (int i = 0; i < 8; ++i) { mm[i] = sM[i * 64 + lane]; M = fmaxf(M, mm[i]); }
    float L = 0.f;
#pragma unroll
    for (int i = 0; i < 8; ++i) { mm[i] = EXP2(mm[i] - M); L += sL[i * 64 + lane] * mm[i]; }
    const float inv = 1.0f / L;
    float r[4];
#pragma unroll
    for (int j = 0; j < 4; ++j) {
      float a = 0.f;
#pragma unroll
      for (int i = 0; i < 8; ++i) a += sO[(i * 16 + dt * 4 + j) * 64 + lane] * mm[i];
      r[j] = a * inv;
    }
    u32x2 v; v.x = pack2(r[0], r[1]); v.y = pack2(r[2], r[3]);
    *(u32x2*)(p.Z + (size_t)(NP + bs * 16 + lr) * LDZ + h * 64 + dt * 16 + lg * 4) = v;
  }
  __syncthreads();
}

__device__ __forceinline__ void run_phase(const Params& p, int ph, unsigned char* smraw, int* sItem) {
  LAS unsigned char* lds = (LAS unsigned char*)smraw;
  const int tid = otid();
#ifdef ONLY_PHASE
  if (ph != ONLY_PHASE) return;
#endif
  switch (ph) {
    case 0: phase0(p, smraw); break;
    case 1: norm_mod(p, 0); break;
    case 2: {
      { EpiZ e{p.Z}; pg8::Gemm g{p.H1, 1024, p.wt_in, 1024, 130, 19}; pg8::gemm_phase(lds, g, e); }
      { EpiKV<1> e{p.KNp, p.VTp, p.KNs, p.VTs}; pg8::Gemm g{p.CKVb, 256, p.wt_ukv, 256, 256, 4}; pg8::gemm_phase(lds, g, e); }
    } break;
    case 3: {
      rowpost(p);
      for (int it = obid(); it < 256; it += gridDim.x) hgrn_run<false>(p, it, smraw);
    } break;
    case 4: {
#ifndef P4SEL
#define P4SEL 3
#endif
      if (P4SEL & 1) { EpiQ e{p.Q, p.tab}; pg8::Gemm g{p.Z, LDZ, p.wt_uq, 384, 130, 3}; pg8::gemm_phase(lds, g, e); }
      if (P4SEL & 2) { EpiKV<0> e{p.KNp, p.VTp, p.KNs, p.VTs}; pg8::Gemm g{p.Z + ZKV, LDZ, p.wt_ukv, 256, 128, 4}; pg8::gemm_phase(lds, g, e); sgemm_rows(p.Z + ZKV, LDZ, p.wt_ukv, 256, 1024, e, (float*)smraw); }
      for (int it = obid(); it < 256; it += gridDim.x) hgrn_scan(p, it);
    } break;
    case 5: {
      const int total = 1024 + 320 + 256;
      for (;;) {
        __syncthreads();
        if (tid == 0) *sItem = (int)atomicAdd(p.ctr, 1u);
        __syncthreads();
        const int it = *sItem;
        if (it >= total) break;
#ifndef ONLY_ITEM
#define ONLY_ITEM 7
#endif
        if (it < 1024) { if (ONLY_ITEM & 1) attn_prompt(p, it, smraw); }
        else if (it < 1024 + 320) { if (ONLY_ITEM & 2) hgrn_run<true>(p, it - 1024, smraw); }
        else { if (ONLY_ITEM & 4) attn_sample(p, it - 1344, smraw); }
      }
    } break;
    case 6: {
      { EpiMixA e{p.Z, p.H}; pg8::Gemm g{p.Z, LDZ, p.wt_pa, 512, 128, 4}; pg8::gemm_phase(lds, g, e); }
      { EpiMixB e{p.Z, p.H}; pg8::Gemm g{p.Z + ZHQ, LDZ, p.wt_pb, 512, 128, 4}; pg8::gemm_phase(lds, g, e); }
      { EpiMixA e{p.Z, p.H}; sgemm_rows(p.Z, LDZ, p.wt_pa, 512, 1024, e, (float*)smraw); }
      { EpiMixB e{p.Z, p.H}; sgemm_rows(p.Z + ZHQ, LDZ, p.wt_pb, 512, 1024, e, (float*)smraw); }
    } break;
    case 7: { EpiRes1 e{p.x_prompt, p.x_sample, p.mod, p.out}; pg8::Gemm g{p.H, 1024, p.wt_out, 1024, 128, 4}; pg8::gemm_phase(lds, g, e); sgemm_rows(p.H, 1024, p.wt_out, 1024, 1024, e, (float*)smraw); } break;
    case 8: norm_mod(p, 1); break;
    case 9: { EpiSwiglu e{p.Z}; pg8::Gemm g{p.H, 1024, p.wt_gu, 1024, 130, 22}; pg8::gemm_phase(lds, g, e); } break;
    case 10: { EpiRes2 e{p.mod, p.out}; pg8::Gemm g{p.Z, 2816, p.wt_dn, 2816, 128, 4}; pg8::gemm_phase(lds, g, e); sgemm_rows(p.Z, 2816, p.wt_dn, 2816, 1024, e, (float*)smraw); } break;
    case 11: final_norm(p); break;
  }
}

__device__ __forceinline__ void xb_setup(unsigned* bar, volatile unsigned* st) {
  if (threadIdx.x == 0) {
    const unsigned x = xb_xcc_id();
    const unsigned G = gridDim.x;
    unsigned cnt = 0u, mine = 1u, sum = 0u, sp = 0u;
    for (;;) {
      sum = 0u; cnt = 0u; mine = 0u;
#pragma unroll
      for (unsigned j = 0; j < 16; ++j) { const unsigned c = xb_ld(&bar[XB_XCNT(j)]); sum += c; cnt += (c > 0u) ? 1u : 0u; mine = (j == x) ? c : mine; }
      if (sum == G) break;
      __builtin_amdgcn_s_sleep(1);
      if ((++sp & 255u) == 0u) { if (xb_ld(&bar[XB_TMO])) break; if (sp > XB_SPIN_CAP) { atomicAdd(&bar[XB_TMO], 1u); break; } }
    }
    st[0] = mine > 0u ? mine : 1u; st[1] = cnt > 0u ? cnt : 1u; st[2] = x;
  }
  __syncthreads();
}

__global__ void __launch_bounds__(NTHR, 2) mega_kernel(Params p) {
  extern __shared__ __attribute__((aligned(16))) unsigned char smraw[];
  int* sItem = (int*)(smraw + STAGE_BYTES);
  cg::grid_group grid = cg::this_grid();
  volatile unsigned* xst = (volatile unsigned*)(smraw + STAGE_BYTES + 16);
  if (blockIdx.x == 0) for (int i = threadIdx.x; i < 4096; i += NTHR) p.ctr[i] = 0u;
  grid.sync();
  if (threadIdx.x == 0) (void)xb_add(&p.ctr[XB_XCNT(xb_xcc_id())], 1u);
#define DO_PHASE(K) if (p.p0 <= (K) && (K) < p.p1) { run_phase(p, (K), smraw, sItem); if ((K) + 1 < p.p1) { if ((K) == 0) xb_setup(p.ctr, xst); xcd_barrier(p.ctr, xst); } }
  DO_PHASE(0) DO_PHASE(1) DO_PHASE(2) DO_PHASE(3) DO_PHASE(4) DO_PHASE(5)
  DO_PHASE(6) DO_PHASE(7) DO_PHASE(8) DO_PHASE(9) DO_PHASE(10) DO_PHASE(11)
}

extern "C" void kernel_launch(void* const* d_in, const int* in_sizes, int n_in, void* d_out, int out_size,
                              void* d_ws, size_t ws_size, hipStream_t stream) {
  static int grid_blocks = 0;
  if (!grid_blocks) {
    int dev = 0, cus = 0, per_cu = 0;
    (void)hipGetDevice(&dev);
    (void)hipDeviceGetAttribute(&cus, hipDeviceAttributeMultiprocessorCount, dev);
    if (hipFuncSetAttribute((const void*)mega_kernel, hipFuncAttributeMaxDynamicSharedMemorySize, LDS_BYTES) != hipSuccess)
      fprintf(stderr, "kernel_launch: hipFuncSetAttribute failed\n");
    (void)hipOccupancyMaxActiveBlocksPerMultiprocessor(&per_cu, (const void*)mega_kernel, NTHR, LDS_BYTES);
    if (per_cu < 1) fprintf(stderr, "kernel_launch: occupancy query says %d blocks/CU\n", per_cu);
    (void)hipGetLastError();
    grid_blocks = cus > 0 ? cus : 256;
  }
  Params p;
  memset(&p, 0, sizeof(p));
  const float* const* in = (const float* const*)d_in;
  p.x_prompt = in[0]; p.x_sample = in[1]; p.cache_ckv = in[2]; p.cache_krope = in[3]; p.state_hgrn = in[4];
  p.c_prompt = in[5]; p.c_sample = in[6]; p.w_in = in[7]; p.q_norm = in[8]; p.w_uq = in[9]; p.kv_norm = in[10];
  p.w_ukv = in[11]; p.lb_param = in[12]; p.hg_norm = in[13]; p.w_pa = in[14]; p.w_pb = in[15]; p.w_out = in[16];
  p.norm1 = in[17]; p.norm2 = in[18]; p.w_ada = in[19]; p.b_ada = in[20]; p.w_gu = in[21]; p.w_down = in[22];
  p.final_norm = in[23];
  p.out = (float*)d_out;
  unsigned char* ws = (unsigned char*)d_ws;
  size_t off = 0;
  auto take = [&](size_t bytes) { unsigned char* r = ws + off; off += (bytes + 255) & ~(size_t)255; return r; };
  p.wt_in = (u16*)take((size_t)4864 * 1024 * 2);
  p.wt_uq = (u16*)take((size_t)768 * 384 * 2);
  p.wt_ukv = (u16*)take((size_t)1024 * 256 * 2);
  p.wt_pa = (u16*)take((size_t)1024 * 512 * 2);
  p.wt_pb = (u16*)take((size_t)1024 * 512 * 2);
  p.wt_out = (u16*)take((size_t)1024 * 1024 * 2);
  p.wt_gu = (u16*)take((size_t)5632 * 1024 * 2);
  p.wt_dn = (u16*)take((size_t)1024 * 2816 * 2);
  p.mod = (float*)take((size_t)34 * 6144 * 4);
  p.tab = (float*)take((size_t)TSEQ * 32 * 4);
  p.ctr = (unsigned*)take(16384);
  p.DEC = (float*)take((size_t)512 * 128 * 4);
  p.HS = (float*)take((size_t)512 * 16384 * 4);
  p.Z = (u16*)take((size_t)NT * LDZ * 2);
  unsigned char* regS = ws + off;
  p.H = (u16*)regS;
  p.KNs = (u16*)regS;
  p.VTs = p.KNs + (size_t)32 * SKV * 512;
  p.KRs = p.VTs + (size_t)32 * 512 * SKV;
  off += (size_t)32 * SKV * 512 * 2 * 2 + (size_t)32 * SKV * 32 * 2;
  if (off > ws_size) { fprintf(stderr, "kernel_launch: workspace too small: need %zu have %zu\n", off, ws_size); return; }
  p.H1 = (u16*)d_out;
  p.Q = (u16*)d_out;
  p.KNp = p.Q + (size_t)NT * 768;
  p.VTp = p.KNp + (size_t)NP * 512;
  p.CKVb = (u16*)((float*)d_out + O_CKVP);
  p.p0 = 0; p.p1 = NPHASE;
  void* args[] = {&p};
  hipError_t e = hipLaunchCooperativeKernel((void*)mega_kernel, dim3(grid_blocks), dim3(NTHR), args, LDS_BYTES, stream);
  if (e != hipSuccess) fprintf(stderr, "cooperative launch failed: %s (grid %d)\n", hipGetErrorString(e), grid_blocks);
}
```

```cpp
#include <hip/hip_runtime.h>
#include <hip/hip_cooperative_groups.h>
#include <cstdio>
#include <cstring>
namespace cg = cooperative_groups;

typedef unsigned short u16;
typedef __attribute__((ext_vector_type(8))) short bf16x8;
typedef __attribute__((ext_vector_type(4))) float f32x4;
typedef __attribute__((ext_vector_type(2))) float f32x2;
typedef __attribute__((ext_vector_type(4))) unsigned u32x4;
typedef __attribute__((ext_vector_type(2))) unsigned u32x2;
#define LAS __attribute__((address_space(3)))

#define NTHR 512
#define NP 32768
#define NS 512
#define NT 33280
#define LDZ 4768
#define ZKV 384
#define ZKR 640
#define ZHQ 672
#define ZHF 1184
#define ZHI 1696
#define ZHG 2208
#define ZGA 2720
#define ZGB 3744
#define SKV 2112
#define TSEQ 16384
#define NPHASE 12

#define O_Y 0
#define O_CKVP 34078720
#define O_KRP 42467328
#define O_HSP 43515904
#define O_CKVS 43646976
#define O_KRS 43778048
#define O_HSS 43794432

#define STAGE_BYTES 131072
#define LDS_BYTES (STAGE_BYTES + 256)
#define HG_LDS 44032

struct Params {
  const float *x_prompt, *x_sample, *cache_ckv, *cache_krope, *state_hgrn, *c_prompt, *c_sample;
  const float *w_in, *q_norm, *w_uq, *kv_norm, *w_ukv, *lb_param, *hg_norm, *w_pa, *w_pb, *w_out;
  const float *norm1, *norm2, *w_ada, *b_ada, *w_gu, *w_down, *final_norm;
  float* out;
  u16 *wt_in, *wt_uq, *wt_ukv, *wt_pa, *wt_pb, *wt_out, *wt_gu, *wt_dn;
  float* mod; float* tab;
  u16* H; u16 *KNs, *VTs, *KRs; u16* Z; float* HS; float* DEC;
  u16 *Q, *KNp, *VTp; u16* H1; u16* CKVb;
  unsigned* ctr;
  int p0, p1;
};

__device__ __forceinline__ bf16x8 mk8(unsigned a, unsigned b, unsigned c, unsigned d) { u32x4 t = {a, b, c, d}; return __builtin_bit_cast(bf16x8, t); }
__device__ __forceinline__ bf16x8 cat8(u32x2 lo, u32x2 hi) { u32x4 t = {lo.x, lo.y, hi.x, hi.y}; return __builtin_bit_cast(bf16x8, t); }

typedef __attribute__((ext_vector_type(2))) __bf16 bf16x2_t;
__device__ __forceinline__ unsigned pack2(float a, float b) { const f32x2 v = {a, b}; return __builtin_bit_cast(unsigned, __builtin_convertvector(v, bf16x2_t)); }
__device__ __forceinline__ u16 f2bf(float f) { return (u16)(pack2(f, f) & 0xffffu); }
__device__ __forceinline__ float bf2f(u16 h) { return __uint_as_float(((unsigned)h) << 16); }
__device__ __forceinline__ float bflo(unsigned u) { return __uint_as_float(u << 16); }
__device__ __forceinline__ float bfhi(unsigned u) { return __uint_as_float(u & 0xffff0000u); }
__device__ __forceinline__ float frcp(float x) { return __builtin_amdgcn_rcpf(x); }
__device__ __forceinline__ float sigmoidf_(float x) { return frcp(1.0f + __expf(-x)); }
__device__ __forceinline__ float siluf_(float x) { return x * frcp(1.0f + __expf(-x)); }
__device__ __forceinline__ float wave_sum(float v) {
#pragma unroll
  for (int o = 32; o > 0; o >>= 1) v += __shfl_xor(v, o);
  return v;
}
__device__ __forceinline__ int otid() { int t = threadIdx.x; asm volatile("" : "+v"(t)); return t; }
__device__ __forceinline__ int obid() { int b = blockIdx.x; asm volatile("" : "+s"(b)); return b; }
#define EXP2(x) __builtin_amdgcn_exp2f(x)
__device__ __forceinline__ float max_x32(float x) { const unsigned u = __float_as_uint(x); auto r = __builtin_amdgcn_permlane32_swap(u, u, false, false); return fmaxf(__uint_as_float(r[0]), __uint_as_float(r[1])); }
__device__ __forceinline__ float max_x16(float x) { const unsigned u = __float_as_uint(x); auto r = __builtin_amdgcn_permlane16_swap(u, u, false, false); return fmaxf(__uint_as_float(r[0]), __uint_as_float(r[1])); }
#define MFMA(a, b, c) __builtin_amdgcn_mfma_f32_16x16x32_bf16((a), (b), (c), 0, 0, 0)

#define XB_TMO      128
#define XB_XCNT(j)  (256  + 64 * (j))
#define XB_XSUB(j)  (1280 + 64 * (j))
#define XB_XGEN(j)  (2304 + 64 * (j))
#define XB_TOP      3328
#define XB_TOPGEN   3392
#define XB_SPIN_CAP (1u << 22)
__device__ __forceinline__ unsigned xb_ld(unsigned* p)              { return __hip_atomic_load(p, __ATOMIC_RELAXED, __HIP_MEMORY_SCOPE_AGENT); }
__device__ __forceinline__ unsigned xb_add(unsigned* p, unsigned v) { return __hip_atomic_fetch_add(p, v, __ATOMIC_RELAXED, __HIP_MEMORY_SCOPE_AGENT); }
__device__ __forceinline__ unsigned xb_xcc_id() { return (unsigned)__builtin_amdgcn_s_getreg((3 << 11) | 20) & 0xFu; }
#define XB_SPIN(cond, bar) do { unsigned _sp = 0; while (cond) { __builtin_amdgcn_s_sleep(1); \
    if ((++_sp & 255u) == 0u) { if (xb_ld(&(bar)[XB_TMO])) break; if (_sp > XB_SPIN_CAP) { atomicAdd(&(bar)[XB_TMO], 1u); break; } } } } while (0)
__device__ __forceinline__ void xcd_barrier(unsigned* bar, volatile unsigned* st  ) {
  asm volatile("s_waitcnt vmcnt(0)" ::: "memory");
  __syncthreads();
  if (threadIdx.x == 0) {
    __builtin_amdgcn_s_waitcnt(0);
    const unsigned nloc = st[0], nx = st[1], x = st[2];
    const unsigned old = xb_add(&bar[XB_XSUB(x)], 1u);
    const unsigned gen = old / nloc;
    if (old + 1u == (gen + 1u) * nloc) {
      __builtin_amdgcn_fence(__ATOMIC_RELEASE, "agent");
      asm volatile("s_waitcnt vmcnt(0)" ::: "memory");
      const unsigned og = xb_add(&bar[XB_TOP], 1u);
      const unsigned tg = og / nx;
      if (og + 1u == (tg + 1u) * nx) xb_add(&bar[XB_TOPGEN], 1u);
      else XB_SPIN(xb_ld(&bar[XB_TOPGEN]) == tg, bar);
      __builtin_amdgcn_fence(__ATOMIC_ACQUIRE, "agent");
      xb_add(&bar[XB_XGEN(x)], 1u);
      asm volatile("s_waitcnt vmcnt(0)" ::: "memory");
    } else {
      XB_SPIN(xb_ld(&bar[XB_XGEN(x)]) == gen, bar);
      __builtin_amdgcn_fence(__ATOMIC_ACQUIRE, "agent");
      asm volatile("s_waitcnt vmcnt(0)" ::: "memory");
    }
  }
  __syncthreads();
}

__device__ __forceinline__ int bidx_of(int row) { return row < NP ? (row >> 14) : 2 + ((row - NP) >> 4); }
__device__ __forceinline__ int pos_of(int row) { return row < NP ? (row & (TSEQ - 1)) : 2048 + ((row - NP) & 15); }

__device__ __forceinline__ void transpose_w(const float* __restrict__ src, u16* __restrict__ dst, int K, int N, int mode, float* tile) {
  const int tid = otid();
  const int nkt = K >> 7, nnt = N >> 5, T = nkt * nnt;
  for (int t = obid(); t < T; t += gridDim.x) {
    const int kt = t % nkt, ntile = t / nkt;
    __syncthreads();
#pragma unroll
    for (int ps = 0; ps < 2; ++ps) {
      const int k = (tid >> 3) + 64 * ps, n4 = (tid & 7) * 4;
      const f32x4 v = *(const f32x4*)(src + (size_t)(kt * 128 + k) * N + ntile * 32 + n4);
      tile[k * 33 + n4 + 0] = v.x; tile[k * 33 + n4 + 1] = v.y; tile[k * 33 + n4 + 2] = v.z; tile[k * 33 + n4 + 3] = v.w;
    }
    __syncthreads();
    {
      const int nl = tid >> 4, kc = tid & 15, n = ntile * 32 + nl;
      float f[8];
#pragma unroll
      for (int i = 0; i < 8; ++i) f[i] = tile[(kc * 8 + i) * 33 + nl];
      int R = n;
      if (mode == 1) R = n < 2816 ? ((n >> 4) * 32 + (n & 15)) : (((n - 2816) >> 4) * 32 + 16 + ((n - 2816) & 15));
      u32x4 o = {pack2(f[0], f[1]), pack2(f[2], f[3]), pack2(f[4], f[5]), pack2(f[6], f[7])};
      *(u32x4*)(dst + (size_t)R * K + kt * 128 + kc * 8) = o;
    }
  }
}

__device__ __forceinline__ void adaln(const Params& p, float* sm) {
  const int tid = otid(), lane = tid & 63, w = tid >> 6;
  for (int it = obid(); it < 96; it += gridDim.x) {
    const int col = it * 64 + lane;
    float acc[34];
#pragma unroll
    for (int b = 0; b < 34; ++b) acc[b] = 0.f;
    float* sC = sm + w * (64 * 36);
    for (int kc = 0; kc < 2; ++kc) {
      const int kb = w * 128 + kc * 64;
      __syncthreads();
#pragma unroll
      for (int b = 0; b < 34; ++b) {
        const float* cr = b < 2 ? p.c_prompt + b * 1024 : p.c_sample + (b - 2) * 1024;
        float c = cr[kb + lane];
        sC[lane * 36 + b] = siluf_(c);
      }
      __syncthreads();
#pragma unroll 8
      for (int kk = 0; kk < 64; ++kk) {
        float wv = p.w_ada[(size_t)(kb + kk) * 6144 + col];
#pragma unroll
        for (int b4 = 0; b4 < 8; ++b4) {
          f32x4 s = *(const f32x4*)&sC[kk * 36 + b4 * 4];
          acc[b4 * 4 + 0] += s.x * wv; acc[b4 * 4 + 1] += s.y * wv; acc[b4 * 4 + 2] += s.z * wv; acc[b4 * 4 + 3] += s.w * wv;
        }
        f32x2 s2 = *(const f32x2*)&sC[kk * 36 + 32];
        acc[32] += s2.x * wv; acc[33] += s2.y * wv;
      }
    }
    __syncthreads();
    float* red = sm;
#pragma unroll
    for (int b = 0; b < 34; ++b) red[(w * 34 + b) * 64 + lane] = acc[b];
    __syncthreads();
    for (int idx = tid; idx < 34 * 64; idx += NTHR) {
      int b = idx >> 6, c = idx & 63;
      float s = 0.f;
#pragma unroll
      for (int ww = 0; ww < 8; ++ww) s += red[(ww * 34 + b) * 64 + c];
      p.mod[b * 6144 + it * 64 + c] = s + p.b_ada[it * 64 + c];
    }
    __syncthreads();
  }
}

__device__ __forceinline__ void phase0(const Params& p, unsigned char* smraw) {
  float* smf = (float*)smraw;
  const int tid = otid();
  adaln(p, smf);
  transpose_w(p.w_in, p.wt_in, 1024, 4768, 0, smf);
  transpose_w(p.w_gu, p.wt_gu, 1024, 5632, 1, smf);
  transpose_w(p.w_down, p.wt_dn, 2816, 1024, 0, smf);
  transpose_w(p.w_out, p.wt_out, 1024, 1024, 0, smf);
  transpose_w(p.w_pa, p.wt_pa, 512, 1024, 0, smf);
  transpose_w(p.w_pb, p.wt_pb, 512, 1024, 0, smf);
  transpose_w(p.w_uq, p.wt_uq, 384, 768, 0, smf);
  transpose_w(p.w_ukv, p.wt_ukv, 256, 1024, 0, smf);
  const size_t gt = (size_t)obid() * NTHR + tid, gn = (size_t)gridDim.x * NTHR;
  for (size_t i = gt; i < (size_t)96 * 1024 / 8; i += gn) *(u32x4*)(p.wt_in + (size_t)4768 * 1024 + i * 8) = (u32x4){0u, 0u, 0u, 0u};
  {
    const int nb = (int)gridDim.x, skip = nb > 96 ? 96 : 0;
    if (obid() >= skip) {
      const size_t ct = (size_t)(obid() - skip) * NTHR + tid, cn = (size_t)(nb - skip) * NTHR;
      for (size_t i = ct; i < (size_t)65536 * 256 / 8; i += cn) {
        const f32x4 a = *(const f32x4*)(p.cache_ckv + i * 8), b = *(const f32x4*)(p.cache_ckv + i * 8 + 4);
        u32x4 o = {pack2(a.x, a.y), pack2(a.z, a.w), pack2(b.x, b.y), pack2(b.z, b.w)};
        *(u32x4*)(p.CKVb + i * 8) = o;
      }
    }
  }
  for (size_t i = gt; i < (size_t)TSEQ * 16; i += gn) {
    const int pos = (int)(i >> 4), j = (int)(i & 15);
    const int jm = j & 3, jd = j >> 2;
    double inv = jm == 0 ? 1.0 : (jm == 1 ? 0.5623413251903491 : (jm == 2 ? 0.31622776601683794 : 0.1778279410038923));
    inv *= (jd == 0 ? 1.0 : (jd == 1 ? 0.1 : (jd == 2 ? 0.01 : 0.001)));
    const double a = (double)pos * inv;
    const double k = rint(a * 0.15915494309189535);
    double r = fma(-k, 6.283185307179586, a);
    r = fma(-k, 2.4492935982947064e-16, r);
    const double r2 = r * r;
    double c = 1.0, s = r, tc = 1.0, ts = r;
#pragma unroll 1
    for (int n = 1; n <= 16; ++n) {
      tc *= -r2 / (double)((2 * n - 1) * (2 * n));
      ts *= -r2 / (double)((2 * n) * (2 * n + 1));
      c += tc; s += ts;
    }
    p.tab[pos * 32 + j] = (float)c;
    p.tab[pos * 32 + 16 + j] = (float)s;
  }
  for (size_t i = gt; i < (size_t)32 * SKV * 32; i += gn) {
    int d = (int)(i & 31); size_t r = i >> 5; int s = (int)(r % SKV); int b = (int)(r / SKV);
    if (s < 2048) p.KRs[i] = f2bf(p.cache_krope[((size_t)b * 2048 + s) * 32 + d]);
    else if (s >= 2064) p.KRs[i] = 0;
  }
  for (size_t i = gt; i < (size_t)32 * 48 * 512; i += gn) {
    int c = (int)(i & 511); size_t r = i >> 9; int s = (int)(r % 48); int b = (int)(r / 48);
    p.KNs[((size_t)b * SKV + 2064 + s) * 512 + c] = 0;
  }
  for (size_t i = gt; i < (size_t)32 * 512 * 48; i += gn) {
    int s = (int)(i % 48); size_t r = i / 48;
    p.VTs[r * SKV + 2064 + s] = 0;
  }
}

#define NR 4
__device__ __forceinline__ void norm_mod(const Params& p, int which) {
  const int tid = otid(), lane = tid & 63, w = tid >> 6;
  const float* nwp = which ? p.norm2 : p.norm1;
  u16* dst = which ? p.H : p.H1;
  for (int row0 = (obid() * 8 + w) * NR; row0 < NT; row0 += gridDim.x * 8 * NR) {
    const float* xr = which ? p.out + (size_t)row0 * 1024
                            : (row0 < NP ? p.x_prompt + (size_t)row0 * 1024 : p.x_sample + (size_t)(row0 - NP) * 1024);
    f32x4 v[NR][4]; float ss[NR];
#pragma unroll
    for (int r = 0; r < NR; ++r)
#pragma unroll
      for (int i = 0; i < 4; ++i) v[r][i] = *(const f32x4*)(xr + r * 1024 + i * 256 + lane * 4);
#pragma unroll
    for (int r = 0; r < NR; ++r) {
      ss[r] = 0.f;
#pragma unroll
      for (int i = 0; i < 4; ++i) ss[r] += v[r][i].x * v[r][i].x + v[r][i].y * v[r][i].y + v[r][i].z * v[r][i].z + v[r][i].w * v[r][i].w;
    }
#pragma unroll
    for (int o = 32; o > 0; o >>= 1) {
#pragma unroll
      for (int r = 0; r < NR; ++r) ss[r] += __shfl_xor(ss[r], o);
    }
    const float* md = p.mod + bidx_of(row0) * 6144 + (which ? 3072 : 0);
#pragma unroll
    for (int i = 0; i < 4; ++i) {
      const int col = i * 256 + lane * 4;
      const f32x4 nw = *(const f32x4*)(nwp + col), sh = *(const f32x4*)(md + col), sc = *(const f32x4*)(md + 1024 + col);
#pragma unroll
      for (int r = 0; r < NR; ++r) {
        const float rstd = rsqrtf(ss[r] * (1.0f / 1024.0f) + 1e-6f);
        float h0 = v[r][i].x * rstd * nw.x * (1.f + sc.x) + sh.x;
        float h1 = v[r][i].y * rstd * nw.y * (1.f + sc.y) + sh.y;
        float h2 = v[r][i].z * rstd * nw.z * (1.f + sc.z) + sh.z;
        float h3 = v[r][i].w * rstd * nw.w * (1.f + sc.w) + sh.w;
        u32x2 o; o.x = pack2(h0, h1); o.y = pack2(h2, h3);
        *(u32x2*)(dst + (size_t)(row0 + r) * 1024 + col) = o;
      }
    }
  }
}

__device__ __forceinline__ void final_norm(const Params& p) {
  const int tid = otid(), lane = tid & 63, w = tid >> 6;
  for (int row0 = (obid() * 8 + w) * NR; row0 < NT; row0 += gridDim.x * 8 * NR) {
    float* xr = p.out + (size_t)row0 * 1024;
    f32x4 v[NR][4]; float ss[NR];
#pragma unroll
    for (int r = 0; r < NR; ++r)
#pragma unroll
      for (int i = 0; i < 4; ++i) v[r][i] = *(const f32x4*)(xr + r * 1024 + i * 256 + lane * 4);
#pragma unroll
    for (int r = 0; r < NR; ++r) {
      ss[r] = 0.f;
#pragma unroll
      for (int i = 0; i < 4; ++i) ss[r] += v[r][i].x * v[r][i].x + v[r][i].y * v[r][i].y + v[r][i].z * v[r][i].z + v[r][i].w * v[r][i].w;
    }
#pragma unroll
    for (int o = 32; o > 0; o >>= 1) {
#pragma unroll
      for (int r = 0; r < NR; ++r) ss[r] += __shfl_xor(ss[r], o);
    }
#pragma unroll
    for (int i = 0; i < 4; ++i) {
      const int col = i * 256 + lane * 4;
      const f32x4 nw = *(const f32x4*)(p.final_norm + col);
#pragma unroll
      for (int r = 0; r < NR; ++r) {
        const float rstd = rsqrtf(ss[r] * (1.0f / 1024.0f) + 1e-6f);
        f32x4 o; o.x = v[r][i].x * rstd * nw.x; o.y = v[r][i].y * rstd * nw.y; o.z = v[r][i].z * rstd * nw.z; o.w = v[r][i].w * rstd * nw.w;
        *(f32x4*)(xr + r * 1024 + col) = o;
      }
    }
  }
}

__device__ __forceinline__ void rowpost(const Params& p) {
  const int tid = otid(), lane = tid & 63, w = tid >> 6;
  for (int row0 = (obid() * 8 + w) * 2; row0 < NT; row0 += gridDim.x * 16) {
    u16 rq[2][6], rk[2][4], rx1[2], rx2[2]; float cs[2], sn[2];
#pragma unroll
    for (int r = 0; r < 2; ++r) {
      const u16* z = p.Z + (size_t)(row0 + r) * LDZ;
#pragma unroll
      for (int i = 0; i < 6; ++i) rq[r][i] = z[i * 64 + lane];
#pragma unroll
      for (int i = 0; i < 4; ++i) rk[r][i] = z[ZKV + i * 64 + lane];
      rx1[r] = z[ZKR + (lane & 15)]; rx2[r] = z[ZKR + 16 + (lane & 15)];
      const int pos = pos_of(row0 + r);
      cs[r] = p.tab[pos * 32 + (lane & 15)]; sn[r] = p.tab[pos * 32 + 16 + (lane & 15)];
    }
    float qn[6], kn[4];
#pragma unroll
    for (int i = 0; i < 6; ++i) qn[i] = p.q_norm[i * 64 + lane];
#pragma unroll
    for (int i = 0; i < 4; ++i) kn[i] = p.kv_norm[i * 64 + lane];
#pragma unroll
    for (int r = 0; r < 2; ++r) {
      const int row = row0 + r;
      u16* z = p.Z + (size_t)row * LDZ;
      float q[6], k[4]; float sq = 0.f, sk = 0.f;
#pragma unroll
      for (int i = 0; i < 6; ++i) { q[i] = bf2f(rq[r][i]); sq += q[i] * q[i]; }
#pragma unroll
      for (int i = 0; i < 4; ++i) { k[i] = bf2f(rk[r][i]); sk += k[i] * k[i]; }
#pragma unroll
      for (int o = 32; o > 0; o >>= 1) { sq += __shfl_xor(sq, o); sk += __shfl_xor(sk, o); }
      const float rq_ = rsqrtf(sq * (1.0f / 384.0f) + 1e-6f), rk_ = rsqrtf(sk * (1.0f / 256.0f) + 1e-6f);
#pragma unroll
      for (int i = 0; i < 6; ++i) z[i * 64 + lane] = f2bf(q[i] * rq_ * qn[i]);
      float* o = row < NP ? p.out + O_CKVP + (size_t)row * 256 : p.out + O_CKVS + (size_t)(row - NP) * 256;
#pragma unroll
      for (int i = 0; i < 4; ++i) {
        const float c = k[i] * rk_ * kn[i];
        o[i * 64 + lane] = c;
        z[ZKV + i * 64 + lane] = f2bf(c);
      }
      if (lane < 16) {
        const float x1 = bf2f(rx1[r]), x2 = bf2f(rx2[r]);
        const float o1 = x1 * cs[r] - x2 * sn[r], o2 = x1 * sn[r] + x2 * cs[r];
        if (row < NP) {
          float* ko = p.out + O_KRP + (size_t)row * 32;
          ko[lane] = o1; ko[16 + lane] = o2;
          z[ZKR + lane] = f2bf(o1); z[ZKR + 16 + lane] = f2bf(o2);
        } else {
          float* ko = p.out + O_KRS + (size_t)(row - NP) * 32;
          ko[lane] = o1; ko[16 + lane] = o2;
          const int bs = (row - NP) >> 4, t = (row - NP) & 15;
          u16* kr = p.KRs + ((size_t)bs * SKV + 2048 + t) * 32;
          kr[lane] = f2bf(o1); kr[16 + lane] = f2bf(o2);
        }
      }
    }
  }
}

namespace pg8 {
constexpr int BM = 256, BK = 64, HALF = 128, HTB = HALF * BK * 2, NXCD = 8, WGM = 4;
__device__ __forceinline__ int lds_byte(int r, int c) { const int st = (r >> 4) * 2 + (c >> 5), rr = r & 15, cc = c & 31, ob = rr * 64 + cc * 2; return st * 1024 + (ob ^ (((ob >> 9) & 1) << 5)); }
__device__ __forceinline__ void stage_rc(int b, int& R, int& C) { const int st = b / 1024, sb = b % 1024, swz = sb ^ (((sb >> 9) & 1) << 5); R = (st >> 1) * 16 + swz / 64; C = (st & 1) * 32 + (swz % 64) / 2; }
struct Unit { int pm, pn; };
struct Gemm { const u16* A; int lda; const u16* Bt; int K, nM, nN; };
struct StaticOrder {
  int nM, nN, nwg, G, c;
  __device__ __forceinline__ void init(int nM_, int nN_, int G_, int c_) { nM = nM_; nN = nN_; nwg = nM * nN; G = G_; c = c_; }
  __device__ __forceinline__ bool next(int i, Unit& u) const {
    const long L = (long)i * G + c; if (L >= nwg) return false;
    int wgid = (int)L; { const int q = nwg / NXCD, r = nwg % NXCD, xcd = wgid % NXCD, off = wgid / NXCD; wgid = (xcd < r ? xcd * (q + 1) : r * (q + 1) + (xcd - r) * q) + off; }
    const int nig = WGM * nN, gid = wgid / nig, fm = gid * WGM, gsz = (nM - fm) < WGM ? (nM - fm) : WGM;
    u.pm = fm + ((wgid % nig) % gsz); u.pn = (wgid % nig) / gsz; return true;
  }
};

template <class Epi>
__device__ __forceinline__ void gemm_phase(LAS unsigned char* lds, const Gemm g, const Epi& E) {
  const int tid = otid(), wid = __builtin_amdgcn_readfirstlane(tid >> 6), lane = tid & 63, wr = wid >> 2, wc = wid & 3, fr = lane & 15, fq = lane >> 4;
  int K_ = g.K; asm volatile("" : "+s"(K_));
  const int K = K_, nt = K / BK;
  StaticOrder S; S.init(g.nM, g.nN, (int)gridDim.x, obid());
  unsigned voffA[2], voffB[2];
#pragma unroll
  for (int i = 0; i < 2; ++i) { int R, C; stage_rc(tid * 16 + i * 8192, R, C);
    voffA[i] = (unsigned)(R * g.lda + C) * 2u; voffB[i] = (unsigned)(R * K + C) * 2u; }
  const size_t kstep = (size_t)(BK * 2);
  const size_t hstepA = (size_t)HALF * g.lda * 2, hstepB = (size_t)HALF * K * 2;
  const size_t tstepA = 2 * hstepA, tstepB = 2 * hstepB;
  const unsigned ldsw = (unsigned)wid * 1024u;
  const int aoff = lds_byte(wr * 64 + fr, fq * 8), boff = lds_byte(wc * 32 + fr, fq * 8);
#define PG8_SA(b, h) (((b) * 2 + (h)) * HTB)
#define PG8_SB(b, h) ((4 + (b) * 2 + (h)) * HTB)
#define PG8_STAGE(bufoff, gbase, voff) do { _Pragma("unroll") for (int _i = 0; _i < 2; ++_i) \
        __builtin_amdgcn_global_load_lds((const unsigned*)((const char*)(gbase) + (voff)[_i]), (LAS unsigned*)(lds + (bufoff) + ldsw + _i * 8192), 16, 0, 0); } while (0)
#define PG8_LDA(dst, b, h) do { _Pragma("unroll") for (int m = 0; m < 4; ++m) _Pragma("unroll") for (int k = 0; k < 2; ++k) dst[m][k] = *(const LAS bf16x8*)(lds + PG8_SA(b, h) + aoff + m * 2048 + k * 1024); } while (0)
#define PG8_LDB(dst, b, h) do { _Pragma("unroll") for (int n = 0; n < 2; ++n) _Pragma("unroll") for (int k = 0; k < 2; ++k) dst[n][k] = *(const LAS bf16x8*)(lds + PG8_SB(b, h) + boff + n * 2048 + k * 1024); } while (0)
#define PG8_MMA(ai, bj, At, Bt) do { __builtin_amdgcn_s_setprio(1); _Pragma("unroll") for (int m = 0; m < 4; ++m) _Pragma("unroll") for (int n = 0; n < 2; ++n) _Pragma("unroll") for (int k = 0; k < 2; ++k) \
        acc[ai][bj][m][n] = __builtin_amdgcn_mfma_f32_16x16x32_bf16(Bt[n][k], At[m][k], acc[ai][bj][m][n], 0, 0, 0); __builtin_amdgcn_s_setprio(0); } while (0)
#define PG8_WAIT_V(n) asm volatile("s_waitcnt vmcnt(" #n ")" ::: "memory")
#define PG8_WAIT_L(n) asm volatile("s_waitcnt lgkmcnt(" #n ")" ::: "memory")
#define PG8_BAR __builtin_amdgcn_s_barrier()
#define PG8_SCHED __builtin_amdgcn_sched_barrier(0)
  Unit cur, nxt; int ui = 0;
  if (!S.next(0, cur)) return;
  f32x4 acc[2][2][4][2];
#pragma unroll
  for (int a = 0; a < 2; ++a)
#pragma unroll
    for (int b = 0; b < 2; ++b)
#pragma unroll
      for (int m = 0; m < 4; ++m)
#pragma unroll
        for (int n = 0; n < 2; ++n) acc[a][b][m][n] = (f32x4){0.f, 0.f, 0.f, 0.f};
  bf16x8 At[4][2], B0[2][2], B1[2][2];
  const char* cA = (const char*)g.A + (size_t)cur.pm * tstepA; const char* cB = (const char*)g.Bt + (size_t)cur.pn * tstepB;
  PG8_WAIT_V(0);
  PG8_STAGE(PG8_SB(0, 0), cB, voffB); PG8_STAGE(PG8_SA(0, 0), cA, voffA); PG8_STAGE(PG8_SB(0, 1), cB + hstepB, voffB); PG8_STAGE(PG8_SA(0, 1), cA + hstepA, voffA);
  if (wr == 1) PG8_BAR;
  PG8_WAIT_V(4); PG8_BAR;
  PG8_STAGE(PG8_SB(1, 0), cB + kstep, voffB); PG8_STAGE(PG8_SA(1, 0), cA + kstep, voffA); PG8_STAGE(PG8_SB(1, 1), cB + hstepB + kstep, voffB);
  PG8_WAIT_V(6); PG8_BAR;
  for (;;) {
    const bool has_next = S.next(ui + 1, nxt);
    const char* nA = has_next ? (const char*)g.A + (size_t)nxt.pm * tstepA : cA; const char* nB = has_next ? (const char*)g.Bt + (size_t)nxt.pn * tstepB : cB;
#pragma unroll 1
    for (int t = 0; t < nt; t += 2) {
      const bool last = (t == nt - 2);
      const char* a1 = cA + (size_t)(t + 1) * kstep;
      const char* a2 = last ? nA : cA + (size_t)(t + 2) * kstep; const char* b2 = last ? nB : cB + (size_t)(t + 2) * kstep;
      const char* a3 = a2 + kstep; const char* b3 = b2 + kstep;
      PG8_LDB(B0, 0, 0); PG8_SCHED; PG8_LDA(At, 0, 0); PG8_STAGE(PG8_SA(1, 1), a1 + hstepA, voffA);
      PG8_WAIT_L(8); PG8_BAR; PG8_WAIT_L(0); PG8_MMA(0, 0, At, B0); PG8_BAR; PG8_SCHED;
      PG8_LDB(B1, 0, 1); PG8_STAGE(PG8_SB(0, 0), b2, voffB);
      PG8_BAR; PG8_WAIT_L(0); PG8_MMA(0, 1, At, B1); PG8_BAR;
      PG8_LDA(At, 0, 1); PG8_STAGE(PG8_SA(0, 0), a2, voffA);
      PG8_BAR; PG8_WAIT_L(0); PG8_MMA(1, 0, At, B0); PG8_BAR; PG8_SCHED;
      PG8_STAGE(PG8_SB(0, 1), b2 + hstepB, voffB);
      PG8_WAIT_V(6); PG8_BAR; PG8_MMA(1, 1, At, B1); PG8_BAR;
      PG8_LDB(B0, 1, 0); PG8_SCHED; PG8_LDA(At, 1, 0); PG8_STAGE(PG8_SA(0, 1), a2 + hstepA, voffA);
      PG8_WAIT_L(8); PG8_BAR; PG8_WAIT_L(0); PG8_MMA(0, 0, At, B0); PG8_BAR; PG8_SCHED;
      PG8_LDB(B1, 1, 1); PG8_STAGE(PG8_SB(1, 0), b3, voffB);
      PG8_BAR; PG8_WAIT_L(0); PG8_MMA(0, 1, At, B1); PG8_BAR;
      PG8_LDA(At, 1, 1); PG8_STAGE(PG8_SA(1, 0), a3, voffA);
      PG8_BAR; PG8_WAIT_L(0); PG8_MMA(1, 0, At, B0); PG8_BAR; PG8_SCHED;
      PG8_STAGE(PG8_SB(1, 1), b3 + hstepB, voffB);
      PG8_WAIT_V(6); PG8_BAR; PG8_MMA(1, 1, At, B1); PG8_BAR;
    }
    {
      const int rowb = cur.pm * BM + wr * 64 + fr, colb = cur.pn * BM + wc * 32 + fq * 4;
      const typename Epi::UPre up = E.uload(rowb, colb);
#pragma unroll
      for (int ai = 0; ai < 2; ++ai) {
        typename Epi::Pre pre[4][2];
#pragma unroll
        for (int m = 0; m < 4; ++m)
#pragma unroll
          for (int bj = 0; bj < 2; ++bj) pre[m][bj] = E.load(rowb + ai * HALF + m * 16, colb + bj * HALF);
#pragma unroll
        for (int m = 0; m < 4; ++m)
#pragma unroll
          for (int bj = 0; bj < 2; ++bj) {
            E(rowb + ai * HALF + m * 16, colb + bj * HALF, acc[ai][bj][m][0], acc[ai][bj][m][1], pre[m][bj], up, bj);
            if (Epi::SERIAL) __builtin_amdgcn_sched_barrier(0);
          }
      }
    }
    if (!has_next) break;
#pragma unroll
    for (int a = 0; a < 2; ++a)
#pragma unroll
      for (int b = 0; b < 2; ++b)
#pragma unroll
        for (int m = 0; m < 4; ++m)
#pragma unroll
          for (int n = 0; n < 2; ++n) acc[a][b][m][n] = (f32x4){0.f, 0.f, 0.f, 0.f};
    cur = nxt; cA = nA; cB = nB; ++ui;
  }
  PG8_WAIT_V(0);
  if (wr == 0) PG8_BAR;
  PG8_BAR;
#undef PG8_SA
#undef PG8_SB
#undef PG8_STAGE
#undef PG8_LDA
#undef PG8_LDB
#undef PG8_MMA
#undef PG8_WAIT_V
#undef PG8_WAIT_L
#undef PG8_BAR
#undef PG8_SCHED
}
}

#define BP(T, base, byteoff) ((T*)((char*)(base) + (unsigned)(byteoff)))
#define CBP(T, base, byteoff) ((const T*)((const char*)(base) + (unsigned)(byteoff)))
struct NoPre {};
struct EpiZ {
  static constexpr bool SERIAL = false;
  typedef NoPre Pre; typedef NoPre UPre;
  u16* Z;
  __device__ __forceinline__ UPre uload(int, int) const { return UPre{}; }
  __device__ __forceinline__ Pre load(int, int) const { return Pre{}; }
  __device__ __forceinline__ void operator()(int row, int cb, f32x4 v0, f32x4 v1, const Pre&, const UPre&, int) const {
    const unsigned o = ((unsigned)row * LDZ + cb) * 2u;
    if (cb < LDZ) { u32x2 t; t.x = pack2(v0[0], v0[1]); t.y = pack2(v0[2], v0[3]); *BP(u32x2, Z, o) = t; }
    if (cb + 16 < LDZ) { u32x2 t; t.x = pack2(v1[0], v1[1]); t.y = pack2(v1[2], v1[3]); *BP(u32x2, Z, o + 32u) = t; }
  }
};
struct EpiQ {
  static constexpr bool SERIAL = false;
  struct Pre { f32x4 cs, sn; };
  typedef NoPre UPre;
  u16* Q; const float* tab;
  __device__ __forceinline__ UPre uload(int, int) const { return UPre{}; }
  __device__ __forceinline__ Pre load(int row, int cb) const {
    Pre r; r.cs = (f32x4){1.f, 1.f, 1.f, 1.f}; r.sn = (f32x4){0.f, 0.f, 0.f, 0.f};
    if ((cb & ~15) % 96 == 64) {
      const unsigned to = ((unsigned)pos_of(row) * 32 + (cb & 15)) * 4u;
      r.cs = *CBP(f32x4, tab, to); r.sn = *CBP(f32x4, tab, to + 64u);
    }
    return r;
  }
  __device__ __forceinline__ void operator()(int row, int cb, f32x4 v0, f32x4 v1, const Pre& pr, const UPre&, int) const {
    const float sc = 0.1472444460259031f;
    if ((cb & ~15) % 96 == 64) {
#pragma unroll
      for (int j = 0; j < 4; ++j) {
        float x1 = v0[j], x2 = v1[j];
        v0[j] = x1 * pr.cs[j] - x2 * pr.sn[j];
        v1[j] = x1 * pr.sn[j] + x2 * pr.cs[j];
      }
    }
    u32x2 o0, o1;
    o0.x = pack2(v0[0] * sc, v0[1] * sc); o0.y = pack2(v0[2] * sc, v0[3] * sc);
    o1.x = pack2(v1[0] * sc, v1[1] * sc); o1.y = pack2(v1[2] * sc, v1[3] * sc);
    const unsigned o = ((unsigned)row * 768 + cb) * 2u;
    *BP(u32x2, Q, o) = o0;
    *BP(u32x2, Q, o + 32u) = o1;
  }
};
__device__ __forceinline__ void kv_store(u16* kn, u16* vt, unsigned knrow, unsigned vtbase, unsigned vstride, int cb, f32x4 v0, f32x4 v1) {
  const int hd = cb >> 7, wi = cb & 127;
  if (wi < 64) {
    u32x2 o0, o1;
    o0.x = pack2(v0[0], v0[1]); o0.y = pack2(v0[2], v0[3]); o1.x = pack2(v1[0], v1[1]); o1.y = pack2(v1[2], v1[3]);
    const unsigned o = (knrow * 512 + hd * 64 + wi) * 2u;
    *BP(u32x2, kn, o) = o0;
    *BP(u32x2, kn, o + 32u) = o1;
  } else {
    const unsigned o = (vtbase + (unsigned)(hd * 64 + wi - 64) * vstride) * 2u;
#pragma unroll
    for (int j = 0; j < 4; ++j) {
      *BP(u16, vt, o + (unsigned)j * vstride * 2u) = f2bf(v0[j]);
      *BP(u16, vt, o + (unsigned)(16 + j) * vstride * 2u) = f2bf(v1[j]);
    }
  }
}
template <int MODE>
struct EpiKV {
  static constexpr bool SERIAL = false;
  typedef NoPre Pre; typedef NoPre UPre;
  u16 *KNp, *VTp, *KNs, *VTs;
  __device__ __forceinline__ UPre uload(int, int) const { return UPre{}; }
  __device__ __forceinline__ Pre load(int, int) const { return Pre{}; }
  __device__ __forceinline__ void operator()(int row, int cb, f32x4 v0, f32x4 v1, const Pre&, const UPre&, int) const {
    if (MODE == 0 && row < NP) {
      kv_store(KNp, VTp, (unsigned)row, (unsigned)(row >> 14) * 512u * TSEQ + (unsigned)(row & (TSEQ - 1)), TSEQ, cb, v0, v1);
    } else {
      unsigned bs, sx;
      if (MODE == 0) { bs = (unsigned)(row - NP) >> 4; sx = 2048u + ((unsigned)(row - NP) & 15u); } else { bs = (unsigned)row >> 11; sx = (unsigned)row & 2047u; }
      kv_store(KNs, VTs, bs * SKV + sx, bs * 512u * SKV + sx, SKV, cb, v0, v1);
    }
  }
};
struct EpiMixA {
  static constexpr bool SERIAL = false;
  struct Pre { u32x2 g[2]; };
  typedef NoPre UPre;
  const u16* Z; u16* MX;
  __device__ __forceinline__ UPre uload(int, int) const { return UPre{}; }
  __device__ __forceinline__ Pre load(int row, int cb) const {
    Pre r; const unsigned o = ((unsigned)row * LDZ + ZGA + cb) * 2u;
    r.g[0] = *CBP(u32x2, Z, o); r.g[1] = *CBP(u32x2, Z, o + 32u); return r;
  }
  __device__ __forceinline__ void operator()(int row, int cb, f32x4 v0, f32x4 v1, const Pre& pr, const UPre&, int) const {
    f32x4 v[2] = {v0, v1};
#pragma unroll
    for (int n = 0; n < 2; ++n) {
      const u32x2 g = pr.g[n];
      u32x2 o;
      o.x = pack2(sigmoidf_(bflo(g.x)) * v[n][0], sigmoidf_(bfhi(g.x)) * v[n][1]);
      o.y = pack2(sigmoidf_(bflo(g.y)) * v[n][2], sigmoidf_(bfhi(g.y)) * v[n][3]);
      *BP(u32x2, MX, ((unsigned)row * 1024 + cb + n * 16) * 2u) = o;
    }
  }
};
struct EpiMixB {
  static constexpr bool SERIAL = false;
  struct Pre { u32x2 g[2]; u32x2 a[2]; };
  typedef NoPre UPre;
  const u16* Z; u16* MX;
  __device__ __forceinline__ UPre uload(int, int) const { return UPre{}; }
  __device__ __forceinline__ Pre load(int row, int cb) const {
    Pre r; const unsigned o = ((unsigned)row * LDZ + ZGB + cb) * 2u, m = ((unsigned)row * 1024 + cb) * 2u;
    r.g[0] = *CBP(u32x2, Z, o); r.g[1] = *CBP(u32x2, Z, o + 32u);
    r.a[0] = *CBP(u32x2, MX, m); r.a[1] = *CBP(u32x2, MX, m + 32u); return r;
  }
  __device__ __forceinline__ void operator()(int row, int cb, f32x4 v0, f32x4 v1, const Pre& pr, const UPre&, int) const {
    f32x4 v[2] = {v0, v1};
#pragma unroll
    for (int n = 0; n < 2; ++n) {
      const u32x2 g = pr.g[n], a = pr.a[n];
      u32x2 o;
      o.x = pack2(bflo(a.x) + sigmoidf_(bflo(g.x)) * v[n][0], bfhi(a.x) + sigmoidf_(bfhi(g.x)) * v[n][1]);
      o.y = pack2(bflo(a.y) + sigmoidf_(bflo(g.y)) * v[n][2], bfhi(a.y) + sigmoidf_(bfhi(g.y)) * v[n][3]);
      *BP(u32x2, MX, ((unsigned)row * 1024 + cb + n * 16) * 2u) = o;
    }
  }
};
struct EpiRes1 {
  static constexpr bool SERIAL = false;
  struct Pre { f32x4 x[2]; };
  struct UPre { f32x4 g[2][2]; };
  const float *xp, *xs, *mod; float* XR;
  __device__ __forceinline__ UPre uload(int row, int colb) const {
    UPre u; const unsigned go = ((unsigned)bidx_of(row) * 6144 + 2048 + colb) * 4u;
#pragma unroll
    for (int bj = 0; bj < 2; ++bj)
#pragma unroll
      for (int n = 0; n < 2; ++n) u.g[bj][n] = *CBP(f32x4, mod, go + bj * 512u + n * 64u);
    return u;
  }
  __device__ __forceinline__ Pre load(int row, int cb) const {
    Pre r;
    const float* base = row < NP ? xp : xs;
    const unsigned o = ((unsigned)(row < NP ? row : row - NP) * 1024 + cb) * 4u;
    r.x[0] = *CBP(f32x4, base, o); r.x[1] = *CBP(f32x4, base, o + 64u);
    return r;
  }
  __device__ __forceinline__ void operator()(int row, int cb, f32x4 v0, f32x4 v1, const Pre& pr, const UPre& up, int bj) const {
    f32x4 v[2] = {v0, v1};
#pragma unroll
    for (int n = 0; n < 2; ++n) {
      const f32x4 x = pr.x[n], gg = up.g[bj][n]; f32x4 o;
      o.x = x.x + gg.x * v[n][0]; o.y = x.y + gg.y * v[n][1]; o.z = x.z + gg.z * v[n][2]; o.w = x.w + gg.w * v[n][3];
      *BP(f32x4, XR, ((unsigned)row * 1024 + cb + n * 16) * 4u) = o;
    }
  }
};
struct EpiRes2 {
  static constexpr bool SERIAL = false;
  struct Pre { f32x4 x[2]; };
  struct UPre { f32x4 g[2][2]; };
  const float* mod; float* XR;
  __device__ __forceinline__ UPre uload(int row, int colb) const {
    UPre u; const unsigned go = ((unsigned)bidx_of(row) * 6144 + 5120 + colb) * 4u;
#pragma unroll
    for (int bj = 0; bj < 2; ++bj)
#pragma unroll
      for (int n = 0; n < 2; ++n) u.g[bj][n] = *CBP(f32x4, mod, go + bj * 512u + n * 64u);
    return u;
  }
  __device__ __forceinline__ Pre load(int row, int cb) const {
    Pre r; const unsigned o = ((unsigned)row * 1024 + cb) * 4u;
    r.x[0] = *CBP(f32x4, XR, o); r.x[1] = *CBP(f32x4, XR, o + 64u); return r;
  }
  __device__ __forceinline__ void operator()(int row, int cb, f32x4 v0, f32x4 v1, const Pre& pr, const UPre& up, int bj) const {
    f32x4 v[2] = {v0, v1};
#pragma unroll
    for (int n = 0; n < 2; ++n) {
      const f32x4 x = pr.x[n], gg = up.g[bj][n]; f32x4 o;
      o.x = x.x + gg.x * v[n][0]; o.y = x.y + gg.y * v[n][1]; o.z = x.z + gg.z * v[n][2]; o.w = x.w + gg.w * v[n][3];
      *BP(f32x4, XR, ((unsigned)row * 1024 + cb + n * 16) * 4u) = o;
    }
  }
};
struct EpiSwiglu {
  static constexpr bool SERIAL = false;
  typedef NoPre Pre; typedef NoPre UPre;
  u16* ACT;
  __device__ __forceinline__ UPre uload(int, int) const { return UPre{}; }
  __device__ __forceinline__ Pre load(int, int) const { return Pre{}; }
  __device__ __forceinline__ void operator()(int row, int cb, f32x4 v0, f32x4 v1, const Pre&, const UPre&, int) const {
    const int acol = ((cb & ~15) >> 5) * 16 + (cb & 15);
    float r[4];
#pragma unroll
    for (int j = 0; j < 4; ++j) { r[j] = siluf_(v0[j]) * v1[j]; }
    u32x2 o; o.x = pack2(r[0], r[1]); o.y = pack2(r[2], r[3]);
    *BP(u32x2, ACT, ((unsigned)row * 2816 + acol) * 2u) = o;
  }
};

template <class Epi>
__device__ __forceinline__ void sgemm_rows(const u16* __restrict__ A, int lda, const u16* __restrict__ Bt, int K, int N, const Epi& E, float* sred) {
  const int tid = otid(), lane = tid & 63, w = tid >> 6, lr = lane & 15, lg = lane >> 4;
  const int quad = w >> 2, kq = w & 3;
  const int ntr = NS >> 4, T = (N >> 5) * ntr, KL = K >> 2;
  for (int base = obid() * 2; base < T; base += gridDim.x * 2) {
    const int t = base + quad;
    const bool valid = t < T;
    const int tr = t % ntr, tc = t / ntr;
    const int erow = NP + tr * 16 + lr, ecb = tc * 32 + lg * 4;
    f32x4 c0 = {0.f, 0.f, 0.f, 0.f}, c1 = {0.f, 0.f, 0.f, 0.f};
    typename Epi::UPre up; typename Epi::Pre pre;
    if (valid && kq == 0) { up = E.uload(erow, ecb); pre = E.load(erow, ecb); }
    if (valid) {
      const u16* a = A + (size_t)(NP + tr * 16 + lr) * lda + kq * KL + lg * 8;
      const u16* b0 = Bt + (size_t)(tc * 32 + lr) * K + kq * KL + lg * 8;
      const u16* b1 = b0 + (size_t)16 * K;
#pragma unroll 4
      for (int k = 0; k < KL; k += 64) {
        bf16x8 fa[2], fb0[2], fb1[2];
#pragma unroll
        for (int i = 0; i < 2; ++i) { fa[i] = *(const bf16x8*)(a + k + i * 32); fb0[i] = *(const bf16x8*)(b0 + k + i * 32); fb1[i] = *(const bf16x8*)(b1 + k + i * 32); }
#pragma unroll
        for (int i = 0; i < 2; ++i) { c0 = MFMA(fb0[i], fa[i], c0); c1 = MFMA(fb1[i], fa[i], c1); }
      }
    }
    __syncthreads();
    if (kq != 0) {
      float* r = sred + ((quad * 3 + (kq - 1)) * 8) * 64 + lane;
#pragma unroll
      for (int j = 0; j < 4; ++j) { r[j * 64] = c0[j]; r[(4 + j) * 64] = c1[j]; }
    }
    __syncthreads();
    if (kq == 0 && valid) {
#pragma unroll
      for (int q = 0; q < 3; ++q) {
        const float* r = sred + ((quad * 3 + q) * 8) * 64 + lane;
#pragma unroll
        for (int j = 0; j < 4; ++j) { c0[j] += r[j * 64]; c1[j] += r[(4 + j) * 64]; }
      }
      E(erow, ecb, c0, c1, pre, up, 0);
    }
  }
}

template <bool outmode>
__device__ __forceinline__ void hgrn_run(const Params& p, int pairitem, unsigned char* smraw0) {
  const int tidf = otid();
  const int half = tidf >> 8;
  unsigned char* smraw = smraw0 + half * HG_LDS;
  const int item = pairitem * 2 + half;
  u16* sQ = (u16*)smraw;
  u16* sK = sQ + 32 * 136;
  u16* sKT = sK + 32 * 136;
  u16* sVT = sKT + 128 * 40;
  u16* sAtt = sVT + 128 * 40;
  float* sDec = (float*)(sAtt + 32 * 40);
  float* sSq = sDec + 128;
  const int tid = tidf & 255, lane = tid & 63, w = tid >> 6, lr = lane & 15, lg = lane >> 4;
  int h, tok0, nblk, nv; size_t hsbase = 0; const float* s0 = nullptr; float* sout = nullptr; int decidx = 0;
  if (item < 512) {
    const int bh = item >> 6, r = item & 63;
    h = bh & 3; tok0 = (bh >> 2) * TSEQ + r * 256; nblk = 8; nv = 32;
    hsbase = (size_t)item << 14; decidx = item * 128;
    if (outmode) s0 = p.HS + hsbase;
  } else {
    const int si = item - 512, bs = si >> 2;
    h = si & 3; tok0 = NP + bs * 16; nblk = 1; nv = 16;
    s0 = p.state_hgrn + ((size_t)si << 14);
    sout = p.out + O_HSS + ((size_t)si << 14);
  }
  f32x4 accS[8][2];
#pragma unroll
  for (int mt = 0; mt < 8; ++mt)
#pragma unroll
    for (int nt = 0; nt < 2; ++nt) {
      if (s0) {
#pragma unroll
        for (int j = 0; j < 4; ++j) accS[mt][nt][j] = s0[(mt * 16 + lg * 4 + j) * 128 + w * 32 + nt * 16 + lr];
      } else accS[mt][nt] = (f32x4){0.f, 0.f, 0.f, 0.f};
    }
  float* sP = sSq + 128;
  const int cp = tid & 63, tg = tid >> 6;
  const float lb0 = sigmoidf_(p.lb_param[h * 128 + 2 * cp] - p.lb_param[512 + h * 128 + 2 * cp]);
  const float lb1 = sigmoidf_(p.lb_param[h * 128 + 2 * cp + 1] - p.lb_param[512 + h * 128 + 2 * cp + 1]);
  const float om0 = 1.0f - lb0, om1 = 1.0f - lb1;
  float dtot0 = 1.f, dtot1 = 1.f;
  const float hgscale = 0.08838834764831845f;
  unsigned rf[8], rq[8], rv[8];
#define HG_LOAD(BLK)                                                                                           \
  {                                                                                                            \
    const u16* zb_ = p.Z + (size_t)(tok0 + (BLK) * 32 + tg * 8) * LDZ + h * 128 + 2 * cp;                      \
    _Pragma("unroll") for (int i = 0; i < 8; ++i) {                                                            \
      if (tg * 8 + i < nv) {                                                                                   \
        const u16* z = zb_ + (size_t)i * LDZ;                                                                  \
        rf[i] = *(const unsigned*)(z + ZHF); rv[i] = *(const unsigned*)(z + ZHI);                              \
        rq[i] = outmode ? *(const unsigned*)(z + ZHQ) : 0u;                                                    \
      } else { rf[i] = 0u; rv[i] = 0u; rq[i] = 0u; }                                                           \
    }                                                                                                          \
  }
  HG_LOAD(0)

#pragma unroll 1
  for (int blk = 0; blk < nblk; ++blk) {
    const int tb = tok0 + blk * 32;
    {
      float eb0 = 1.f, eb1 = 1.f;
      float q0[8], q1[8], k0[8], k1[8];
#pragma unroll
      for (int i = 0; i < 8; ++i) {
        q0[i] = 0.f; q1[i] = 0.f; k0[i] = 0.f; k1[i] = 0.f;
        if (tg * 8 + i < nv) {
          const float e0 = __expf(-bflo(rf[i])), e1 = __expf(-bfhi(rf[i]));
          const float s0_ = frcp(1.0f + e0), s1_ = frcp(1.0f + e1);
          eb0 *= lb0 + om0 * s0_; eb1 *= lb1 + om1 * s1_;
          k0[i] = om0 * e0 * s0_ * frcp(eb0); k1[i] = om1 * e1 * s1_ * frcp(eb1);
          if (outmode) { q0[i] = siluf_(bflo(rq[i])) * hgscale * eb0; q1[i] = siluf_(bfhi(rq[i])) * hgscale * eb1; }
        }
      }
      sP[tg * 128 + 2 * cp] = eb0; sP[tg * 128 + 2 * cp + 1] = eb1;
      __syncthreads();
      float pre0 = 1.f, pre1 = 1.f;
#pragma unroll
      for (int g = 0; g < 3; ++g) if (g < tg) { pre0 *= sP[g * 128 + 2 * cp]; pre1 *= sP[g * 128 + 2 * cp + 1]; }
      if (tg == 3) { const float d0 = pre0 * eb0, d1 = pre1 * eb1; sDec[2 * cp] = d0; sDec[2 * cp + 1] = d1; dtot0 *= d0; dtot1 *= d1; }
      const float in0 = frcp(pre0), in1 = frcp(pre1);
#pragma unroll
      for (int i = 0; i < 8; ++i) {
        k0[i] *= in0; k1[i] *= in1;
        if (outmode) {
          const int t = tg * 8 + i;
          *(unsigned*)&sQ[t * 136 + 2 * cp] = pack2(q0[i] * pre0, q1[i] * pre1);
          *(unsigned*)&sK[t * 136 + 2 * cp] = pack2(k0[i], k1[i]);
        }
      }
      { u32x4 a = {pack2(k0[0], k0[1]), pack2(k0[2], k0[3]), pack2(k0[4], k0[5]), pack2(k0[6], k0[7])};
        u32x4 c = {pack2(k1[0], k1[1]), pack2(k1[2], k1[3]), pack2(k1[4], k1[5]), pack2(k1[6], k1[7])};
        *(u32x4*)&sKT[(2 * cp) * 40 + tg * 8] = a; *(u32x4*)&sKT[(2 * cp + 1) * 40 + tg * 8] = c; }
      { u32x4 a, c;
        a.x = (rv[0] & 0xffffu) | (rv[1] << 16); a.y = (rv[2] & 0xffffu) | (rv[3] << 16);
        a.z = (rv[4] & 0xffffu) | (rv[5] << 16); a.w = (rv[6] & 0xffffu) | (rv[7] << 16);
        c.x = (rv[0] >> 16) | (rv[1] & 0xffff0000u); c.y = (rv[2] >> 16) | (rv[3] & 0xffff0000u);
        c.z = (rv[4] >> 16) | (rv[5] & 0xffff0000u); c.w = (rv[6] >> 16) | (rv[7] & 0xffff0000u);
        *(u32x4*)&sVT[(2 * cp) * 40 + tg * 8] = a; *(u32x4*)&sVT[(2 * cp + 1) * 40 + tg * 8] = c; }
    }
    __syncthreads();
    if (blk + 1 < nblk) HG_LOAD(blk + 1)
    f32x4 ot[2][2];
    if (outmode) {
      {
        const int si = w & 1, ti = w >> 1;
        f32x4 at = (f32x4){0.f, 0.f, 0.f, 0.f};
#pragma unroll
        for (int ks = 0; ks < 4; ++ks) {
          bf16x8 a = *(const bf16x8*)&sK[(si * 16 + lr) * 136 + ks * 32 + lg * 8];
          bf16x8 b = *(const bf16x8*)&sQ[(ti * 16 + lr) * 136 + ks * 32 + lg * 8];
          at = MFMA(a, b, at);
        }
        const int t = ti * 16 + lr, sb = si * 16 + lg * 4;
        float m0 = (sb + 0 <= t) ? at[0] : 0.f, m1 = (sb + 1 <= t) ? at[1] : 0.f, m2 = (sb + 2 <= t) ? at[2] : 0.f, m3 = (sb + 3 <= t) ? at[3] : 0.f;
        u32x2 o; o.x = pack2(m0, m1); o.y = pack2(m2, m3);
        *(u32x2*)&sAtt[t * 40 + sb] = o;
      }
      __syncthreads();
#pragma unroll
      for (int vt = 0; vt < 2; ++vt)
#pragma unroll
        for (int tt = 0; tt < 2; ++tt) ot[vt][tt] = (f32x4){0.f, 0.f, 0.f, 0.f};
      {
        bf16x8 bq[2];
#pragma unroll
        for (int tt = 0; tt < 2; ++tt) bq[tt] = *(const bf16x8*)&sAtt[(tt * 16 + lr) * 40 + lg * 8];
#pragma unroll
        for (int vt = 0; vt < 2; ++vt) {
          bf16x8 a = *(const bf16x8*)&sVT[(w * 32 + vt * 16 + lr) * 40 + lg * 8];
#pragma unroll
          for (int tt = 0; tt < 2; ++tt) ot[vt][tt] = MFMA(a, bq[tt], ot[vt][tt]);
        }
      }
#pragma unroll
      for (int kk = 0; kk < 4; ++kk) {
        bf16x8 bq[2];
#pragma unroll
        for (int tt = 0; tt < 2; ++tt)
          bq[tt] = cat8(*(const u32x2*)&sQ[(tt * 16 + lr) * 136 + (2 * kk) * 16 + lg * 4],
                        *(const u32x2*)&sQ[(tt * 16 + lr) * 136 + (2 * kk + 1) * 16 + lg * 4]);
#pragma unroll
        for (int vt = 0; vt < 2; ++vt) {
          bf16x8 a = mk8(pack2(accS[2 * kk][vt][0], accS[2 * kk][vt][1]), pack2(accS[2 * kk][vt][2], accS[2 * kk][vt][3]),
                         pack2(accS[2 * kk + 1][vt][0], accS[2 * kk + 1][vt][1]), pack2(accS[2 * kk + 1][vt][2], accS[2 * kk + 1][vt][3]));
#pragma unroll
          for (int tt = 0; tt < 2; ++tt) ot[vt][tt] = MFMA(a, bq[tt], ot[vt][tt]);
        }
      }
    }
    {
      bf16x8 bv[2];
#pragma unroll
      for (int nt = 0; nt < 2; ++nt) bv[nt] = *(const bf16x8*)&sVT[(w * 32 + nt * 16 + lr) * 40 + lg * 8];
#pragma unroll
      for (int mt = 0; mt < 8; ++mt) {
        bf16x8 a = *(const bf16x8*)&sKT[(mt * 16 + lr) * 40 + lg * 8];
        f32x4 dc = *(const f32x4*)&sDec[mt * 16 + lg * 4];
#pragma unroll
        for (int nt = 0; nt < 2; ++nt) {
          f32x4 r = MFMA(a, bv[nt], accS[mt][nt]);
          r[0] *= dc.x; r[1] *= dc.y; r[2] *= dc.z; r[3] *= dc.w;
          accS[mt][nt] = r;
        }
      }
    }
    if (outmode) {
#pragma unroll
      for (int tt = 0; tt < 2; ++tt) {
        float ss = 0.f;
#pragma unroll
        for (int vt = 0; vt < 2; ++vt)
#pragma unroll
          for (int j = 0; j < 4; ++j) ss += ot[vt][tt][j] * ot[vt][tt][j];
        ss += __shfl_xor(ss, 16); ss += __shfl_xor(ss, 32);
        if (lg == 0) sSq[w * 32 + tt * 16 + lr] = ss;
      }
      __syncthreads();
#pragma unroll
      for (int tt = 0; tt < 2; ++tt) {
        const int t = tt * 16 + lr;
        const float tot = sSq[t] + sSq[32 + t] + sSq[64 + t] + sSq[96 + t];
        const float rstd = rsqrtf(tot * (1.0f / 128.0f) + 1e-6f);
        if (t < nv) {
          u16* z = p.Z + (size_t)(tb + t) * LDZ + h * 128;
#pragma unroll
          for (int vt = 0; vt < 2; ++vt) {
            const int vch = w * 32 + vt * 16 + lg * 4;
            u32x2 g = *(const u32x2*)(z + ZHG + vch);
            f32x4 nw = *(const f32x4*)(p.hg_norm + vch);
            float g0 = bflo(g.x), g1 = bfhi(g.x), g2 = bflo(g.y), g3 = bfhi(g.y);
            float r0 = ot[vt][tt][0] * rstd * nw.x * siluf_(g0);
            float r1 = ot[vt][tt][1] * rstd * nw.y * siluf_(g1);
            float r2 = ot[vt][tt][2] * rstd * nw.z * siluf_(g2);
            float r3 = ot[vt][tt][3] * rstd * nw.w * siluf_(g3);
            u32x2 o; o.x = pack2(r0, r1); o.y = pack2(r2, r3);
            *(u32x2*)(z + ZHQ + vch) = o;
          }
        }
      }
    }
    __syncthreads();
  }
  if (!outmode) {
#pragma unroll
    for (int mt = 0; mt < 8; ++mt)
#pragma unroll
      for (int nt = 0; nt < 2; ++nt)
#pragma unroll
        for (int j = 0; j < 4; ++j) p.HS[hsbase + (mt * 16 + lg * 4 + j) * 128 + w * 32 + nt * 16 + lr] = accS[mt][nt][j];
    if (tg == 3) { p.DEC[decidx + 2 * cp] = dtot0; p.DEC[decidx + 2 * cp + 1] = dtot1; }
  } else if (sout) {
#pragma unroll
    for (int mt = 0; mt < 8; ++mt)
#pragma unroll
      for (int nt = 0; nt < 2; ++nt)
#pragma unroll
        for (int j = 0; j < 4; ++j) sout[(mt * 16 + lg * 4 + j) * 128 + w * 32 + nt * 16 + lr] = accS[mt][nt][j];
  }
}

__device__ __forceinline__ void hgrn_scan(const Params& p, int it) {
  const int e = it * NTHR + otid();
  const int bh = e >> 14, rem = e & 16383, kch = rem >> 7;
  float S = 0.f;
#pragma unroll 1
  for (int r0 = 0; r0 < 64; r0 += 16) {
    float L[16], d[16];
#pragma unroll
    for (int i = 0; i < 16; ++i) {
      L[i] = p.HS[((size_t)(bh * 64 + r0 + i) << 14) + rem];
      d[i] = p.DEC[(bh * 64 + r0 + i) * 128 + kch];
    }
#pragma unroll
    for (int i = 0; i < 16; ++i) {
      p.HS[((size_t)(bh * 64 + r0 + i) << 14) + rem] = S;
      S = d[i] * S + L[i];
    }
  }
  p.out[O_HSP + e] = S;
}

typedef __attribute__((ext_vector_type(16))) float f32x16;
#define MFMA32(a, b, c) __builtin_amdgcn_mfma_f32_32x32x16_bf16((a), (b), (c), 0, 0, 0)
__device__ __forceinline__ void attn_prompt(const Params& p, int item, unsigned char* smraw) {
  u16* sb0 = (u16*)smraw;
  const int tid = otid(), lane = tid & 63, w = tid >> 6, lq = lane & 31, hh = lane >> 5;
  const int qb = 63 - (item >> 4), bh = item & 15, b = bh >> 3, h = bh & 7;
  const int ntr = 2 * qb + 2;
  const int nvis = 4 * qb + (w >> 1) + 1;
  const int q0 = b * TSEQ + qb * 256 + w * 32;
  bf16x8 qf[6];
#pragma unroll
  for (int ks = 0; ks < 6; ++ks) qf[ks] = *(const bf16x8*)(p.Q + (size_t)(q0 + lq) * 768 + h * 96 + ks * 16 + hh * 8);
  f32x16 ot[2];
#pragma unroll
  for (int dt = 0; dt < 2; ++dt)
#pragma unroll
    for (int r = 0; r < 16; ++r) ot[dt][r] = 0.f;
  float nm = 0.f, lrun = 0.f;
  bool first = true;
  u32x4 rk[2], rr, rv[2];
#define ATT_BUF_U16 22016
#define ATT_LOAD(TR)                                                                                          \
  {                                                                                                           \
    const int kb_ = b * TSEQ + (TR) * 128;                                                                    \
    _Pragma("unroll") for (int i = 0; i < 2; ++i) {                                                           \
      const int c_ = tid + i * 512;                                                                           \
      rk[i] = *(const u32x4*)(p.KNp + (size_t)(kb_ + (c_ >> 3)) * 512 + h * 64 + (c_ & 7) * 8);              \
      rv[i] = *(const u32x4*)(p.VTp + ((size_t)(b * 512 + h * 64 + (c_ >> 4))) * TSEQ + (TR) * 128 + (c_ & 15) * 8); \
    }                                                                                                         \
    rr = *(const u32x4*)(p.Z + (size_t)(kb_ + (tid >> 2)) * LDZ + ZKR + (tid & 3) * 8);                       \
  }
#define ATT_WRITE(BI)                                                                                         \
  {                                                                                                           \
    u16* k_ = sb0 + (BI) * ATT_BUF_U16; u16* v_ = k_ + 128 * 104;                                             \
    _Pragma("unroll") for (int i = 0; i < 2; ++i) {                                                           \
      const int c_ = tid + i * 512;                                                                           \
      *(u32x4*)&k_[(c_ >> 3) * 104 + (c_ & 7) * 8] = rk[i];                                                   \
      u16* vd_ = &v_[(c_ >> 4) * 136 + ((c_ & 15) >> 1) * 16 + (c_ & 1) * 4];     \
      *(u32x2*)vd_ = (u32x2){rv[i].x, rv[i].y}; *(u32x2*)(vd_ + 8) = (u32x2){rv[i].z, rv[i].w};               \
    }                                                                                                         \
    *(u32x4*)&k_[(tid >> 2) * 104 + 64 + (tid & 3) * 8] = rr;                                                 \
  }
  ATT_LOAD(0)
  ATT_WRITE(0)
  ATT_LOAD(1)
  __syncthreads();
#pragma unroll 1
  for (int tr = 0; tr < ntr; ++tr) {
    if (tr + 1 < ntr) ATT_WRITE((tr + 1) & 1)
    if (tr + 2 < ntr) ATT_LOAD(tr + 2)
    const u16* sK = sb0 + (tr & 1) * ATT_BUF_U16;
    const u16* sVT = sK + 128 * 104;
    if (2 * tr >= nvis) { __syncthreads(); continue; }
    const bool halfvis = (2 * tr + 1 >= nvis);
    f32x16 st[4];
    f32x16 nmv;
#pragma unroll
    for (int r = 0; r < 16; ++r) nmv[r] = nm;
#pragma unroll
    for (int kt = 0; kt < 4; ++kt) {
      const bf16x8 kf = *(const bf16x8*)&sK[(kt * 32 + lq) * 104 + hh * 8];
      st[kt] = MFMA32(kf, qf[0], nmv);
    }
#pragma unroll
    for (int ks = 1; ks < 6; ++ks)
#pragma unroll
      for (int kt = 0; kt < 4; ++kt) {
        const bf16x8 kf = *(const bf16x8*)&sK[(kt * 32 + lq) * 104 + ks * 16 + hh * 8];
        st[kt] = MFMA32(kf, qf[ks], st[kt]);
      }
    if (__any(halfvis)) {
#pragma unroll
      for (int kt = 2; kt < 4; ++kt)
#pragma unroll
        for (int r = 0; r < 16; ++r) st[kt][r] = -INFINITY;
    }
    {
      float mx = fmaxf(fmaxf(st[0][0], st[0][1]), st[0][2]);
#pragma unroll
      for (int r = 3; r < 16; r += 2) mx = fmaxf(fmaxf(mx, st[0][r]), st[0][r + 1 < 16 ? r + 1 : r]);
#pragma unroll
      for (int kt = 1; kt < 4; ++kt)
#pragma unroll
        for (int r = 0; r < 16; r += 2) mx = fmaxf(fmaxf(mx, st[kt][r]), st[kt][r + 1]);
      mx = max_x32(mx);
      if (first || __any(mx > 8.0f)) {
        const float delta = first ? mx : fmaxf(mx, 0.f);
#pragma unroll
        for (int kt = 0; kt < 4; ++kt)
#pragma unroll
          for (int r = 0; r < 16; ++r) st[kt][r] -= delta;
        nm -= delta;
        if (!first) {
          const float alpha = EXP2(-delta);
          lrun *= alpha;
#pragma unroll
          for (int dt = 0; dt < 2; ++dt)
#pragma unroll
            for (int r = 0; r < 16; ++r) ot[dt][r] *= alpha;
        }
      }
      float ps0 = 0.f, ps1 = 0.f;
#pragma unroll
      for (int kt = 0; kt < 4; ++kt)
#pragma unroll
        for (int r = 0; r < 16; r += 2) {
          const float e0 = EXP2(st[kt][r]), e1 = EXP2(st[kt][r + 1]);
          st[kt][r] = e0; st[kt][r + 1] = e1;
          ps0 += e0; ps1 += e1;
        }
      lrun += ps0 + ps1;
    }
    first = false;
#pragma unroll
    for (int kt = 0; kt < 4; ++kt)
#pragma unroll
      for (int s2 = 0; s2 < 2; ++s2) {
        const bf16x8 pb = mk8(pack2(st[kt][8 * s2 + 0], st[kt][8 * s2 + 1]), pack2(st[kt][8 * s2 + 2], st[kt][8 * s2 + 3]),
                              pack2(st[kt][8 * s2 + 4], st[kt][8 * s2 + 5]), pack2(st[kt][8 * s2 + 6], st[kt][8 * s2 + 7]));
#pragma unroll
        for (int dt = 0; dt < 2; ++dt) {
          const bf16x8 a = *(const bf16x8*)&sVT[(dt * 32 + lq) * 136 + kt * 32 + 16 * s2 + 8 * hh];
          ot[dt] = MFMA32(a, pb, ot[dt]);
        }
      }
    __syncthreads();
  }
#undef ATT_WRITE
#undef ATT_LOAD
  {
    float l = lrun;
    l += __shfl_xor(l, 32);
    const float inv = 1.0f / l;
    u16* o = p.Z + (size_t)(q0 + lq) * LDZ + h * 64;
#pragma unroll
    for (int dt = 0; dt < 2; ++dt)
#pragma unroll
      for (int rg = 0; rg < 4; ++rg) {
        u32x2 v; v.x = pack2(ot[dt][4 * rg + 0] * inv, ot[dt][4 * rg + 1] * inv); v.y = pack2(ot[dt][4 * rg + 2] * inv, ot[dt][4 * rg + 3] * inv);
        *(u32x2*)(o + dt * 32 + 8 * rg + 4 * hh) = v;
      }
  }
}

__device__ __forceinline__ void attn_sample(const Params& p, int item, unsigned char* smraw) {
  float* sM = (float*)smraw;
  float* sL = sM + 512;
  float* sO = sL + 512;
  const int tid = otid(), lane = tid & 63, w = tid >> 6, lr = lane & 15, lg = lane >> 4;
  const int bs = item >> 3, h = item & 7;
  bf16x8 qf[3];
#pragma unroll
  for (int ks = 0; ks < 3; ++ks) qf[ks] = *(const bf16x8*)(p.Q + (size_t)(NP + bs * 16 + lr) * 768 + h * 96 + ks * 32 + lg * 8);
  f32x4 ot[4];
#pragma unroll
  for (int dt = 0; dt < 4; ++dt) ot[dt] = (f32x4){0.f, 0.f, 0.f, 0.f};
  float mrun = -INFINITY, lrun = 0.f;
  for (int kt = w; kt < 33; kt += 8) {
    const size_t kb = (size_t)bs * SKV + kt * 64;
    f32x4 st[4];
#pragma unroll
    for (int a = 0; a < 4; ++a) st[a] = (f32x4){0.f, 0.f, 0.f, 0.f};
#pragma unroll
    for (int a = 0; a < 4; ++a) {
      const size_t krow = kb + a * 16 + lr;
      bf16x8 k0 = *(const bf16x8*)(p.KNs + krow * 512 + h * 64 + lg * 8);
      bf16x8 k1 = *(const bf16x8*)(p.KNs + krow * 512 + h * 64 + 32 + lg * 8);
      bf16x8 k2 = *(const bf16x8*)(p.KRs + krow * 32 + lg * 8);
      st[a] = MFMA(k0, qf[0], st[a]); st[a] = MFMA(k1, qf[1], st[a]); st[a] = MFMA(k2, qf[2], st[a]);
    }
    if (kt == 32) {
#pragma unroll
      for (int a = 1; a < 4; ++a) st[a] = (f32x4){-INFINITY, -INFINITY, -INFINITY, -INFINITY};
    }
    float mx = st[0][0];
#pragma unroll
    for (int a = 0; a < 4; ++a)
#pragma unroll
      for (int j = 0; j < 4; ++j) mx = fmaxf(mx, st[a][j]);
    mx = fmaxf(mx, __shfl_xor(mx, 16)); mx = fmaxf(mx, __shfl_xor(mx, 32));
    const float mnew = fmaxf(mrun, mx);
    const float alpha = EXP2(mrun - mnew);
    mrun = mnew;
    float ps = 0.f;
#pragma unroll
    for (int a = 0; a < 4; ++a)
#pragma unroll
      for (int j = 0; j < 4; ++j) { float e = EXP2(st[a][j] - mnew); st[a][j] = e; ps += e; }
    lrun = lrun * alpha + ps;
#pragma unroll
    for (int dt = 0; dt < 4; ++dt) { ot[dt][0] *= alpha; ot[dt][1] *= alpha; ot[dt][2] *= alpha; ot[dt][3] *= alpha; }
#pragma unroll
    for (int s = 0; s < 2; ++s) {
      bf16x8 pb = mk8(pack2(st[2 * s][0], st[2 * s][1]), pack2(st[2 * s][2], st[2 * s][3]),
                      pack2(st[2 * s + 1][0], st[2 * s + 1][1]), pack2(st[2 * s + 1][2], st[2 * s + 1][3]));
#pragma unroll
      for (int dt = 0; dt < 4; ++dt) {
        const u16* vr = p.VTs + ((size_t)bs * 512 + h * 64 + dt * 16 + lr) * SKV + kt * 64;
        bf16x8 a = cat8(*(const u32x2*)(vr + (2 * s) * 16 + lg * 4), *(const u32x2*)(vr + (2 * s + 1) * 16 + lg * 4));
        ot[dt] = MFMA(a, pb, ot[dt]);
      }
    }
  }
  lrun += __shfl_xor(lrun, 16); lrun += __shfl_xor(lrun, 32);
  __syncthreads();
  sM[w * 64 + lane] = mrun; sL[w * 64 + lane] = lrun;
#pragma unroll
  for (int dt = 0; dt < 4; ++dt)
#pragma unroll
    for (int j = 0; j < 4; ++j) sO[(w * 16 + dt * 4 + j) * 64 + lane] = ot[dt][j];
  __syncthreads();
  if (w < 4) {
    const int dt = w;
    float mm[8], M = -INFINITY;
#pragma unroll
    for (int i = 0; i < 8; ++i) { mm[i] = sM[i * 64 + lane]; M = fmaxf(M, mm[i]); }
    float L = 0.f;
#pragma unroll
    for (int i = 0; i < 8; ++i) { mm[i] = EXP2(mm[i] - M); L += sL[i * 64 + lane] * mm[i]; }
    const float inv = 1.0f / L;
    float r[4];
#pragma unroll
    for (int j = 0; j < 4; ++j) {
      float a = 0.f;
#pragma unroll
      for (int i = 0; i < 8; ++i) a += sO[(i * 16 + dt * 4 + j) * 64 + lane] * mm[i];
      r[j] = a * inv;
    }
    u32x2 v; v.x = pack2(r[0], r[1]); v.y = pack2(r[2], r[3]);
    *(u32x2*)(p.Z + (size_t)(NP + bs * 16 + lr) * LDZ + h * 64 + dt * 16 + lg * 4) = v;
  }
  __syncthreads();
}

__device__ __forceinline__ void run_phase(const Params& p, int ph, unsigned char* smraw, int* sItem) {
  LAS unsigned char* lds = (LAS unsigned char*)smraw;
  const int tid = otid();
#ifdef ONLY_PHASE
  if (ph != ONLY_PHASE) return;
#endif
  switch (ph) {
    case 0: phase0(p, smraw); break;
    case 1: norm_mod(p, 0); break;
    case 2: {
      { EpiZ e{p.Z}; pg8::Gemm g{p.H1, 1024, p.wt_in, 1024, 130, 19}; pg8::gemm_phase(lds, g, e); }
      { EpiKV<1> e{p.KNp, p.VTp, p.KNs, p.VTs}; pg8::Gemm g{p.CKVb, 256, p.wt_ukv, 256, 256, 4}; pg8::gemm_phase(lds, g, e); }
    } break;
    case 3: {
      rowpost(p);
      for (int it = obid(); it < 256; it += gridDim.x) hgrn_run<false>(p, it, smraw);
    } break;
    case 4: {
#ifndef P4SEL
#define P4SEL 3
#endif
      if (P4SEL & 1) { EpiQ e{p.Q, p.tab}; pg8::Gemm g{p.Z, LDZ, p.wt_uq, 384, 130, 3}; pg8::gemm_phase(lds, g, e); }
      if (P4SEL & 2) { EpiKV<0> e{p.KNp, p.VTp, p.KNs, p.VTs}; pg8::Gemm g{p.Z + ZKV, LDZ, p.wt_ukv, 256, 128, 4}; pg8::gemm_phase(lds, g, e); sgemm_rows(p.Z + ZKV, LDZ, p.wt_ukv, 256, 1024, e, (float*)smraw); }
      for (int it = obid(); it < 256; it += gridDim.x) hgrn_scan(p, it);
    } break;
    case 5: {
      const int total = 1024 + 320 + 256;
      for (;;) {
        __syncthreads();
        if (tid == 0) *sItem = (int)atomicAdd(p.ctr, 1u);
        __syncthreads();
        const int it = *sItem;
        if (it >= total) break;
#ifndef ONLY_ITEM
#define ONLY_ITEM 7
#endif
        if (it < 1024) { if (ONLY_ITEM & 1) attn_prompt(p, it, smraw); }
        else if (it < 1024 + 320) { if (ONLY_ITEM & 2) hgrn_run<true>(p, it - 1024, smraw); }
        else { if (ONLY_ITEM & 4) attn_sample(p, it - 1344, smraw); }
      }
    } break;
    case 6: {
      { EpiMixA e{p.Z, p.H}; pg8::Gemm g{p.Z, LDZ, p.wt_pa, 512, 128, 4}; pg8::gemm_phase(lds, g, e); }
      { EpiMixB e{p.Z, p.H}; pg8::Gemm g{p.Z + ZHQ, LDZ, p.wt_pb, 512, 128, 4}; pg8::gemm_phase(lds, g, e); }
      { EpiMixA e{p.Z, p.H}; sgemm_rows(p.Z, LDZ, p.wt_pa, 512, 1024, e, (float*)smraw); }
      { EpiMixB e{p.Z, p.H}; sgemm_rows(p.Z + ZHQ, LDZ, p.wt_pb, 512, 1024, e, (float*)smraw); }
    } break;
    case 7: { EpiRes1 e{p.x_prompt, p.x_sample, p.mod, p.out}; pg8::Gemm g{p.H, 1024, p.wt_out, 1024, 128, 4}; pg8::gemm_phase(lds, g, e); sgemm_rows(p.H, 1024, p.wt_out, 1024, 1024, e, (float*)smraw); } break;
    case 8: norm_mod(p, 1); break;
    case 9: { EpiSwiglu e{p.Z}; pg8::Gemm g{p.H, 1024, p.wt_gu, 1024, 130, 22}; pg8::gemm_phase(lds, g, e); } break;
    case 10: { EpiRes2 e{p.mod, p.out}; pg8::Gemm g{p.Z, 2816, p.wt_dn, 2816, 128, 4}; pg8::gemm_phase(lds, g, e); sgemm_rows(p.Z, 2816, p.wt_dn, 2816, 1024, e, (float*)smraw); } break;
    case 11: final_norm(p); break;
  }
}

__device__ __forceinline__ void xb_setup(unsigned* bar, volatile unsigned* st) {
  if (threadIdx.x == 0) {
    const unsigned x = xb_xcc_id();
    const unsigned G = gridDim.x;
    unsigned cnt = 0u, mine = 1u, sum = 0u, sp = 0u;
    for (;;) {
      sum = 0u; cnt = 0u; mine = 0u;
#pragma unroll
      for (unsigned j = 0; j < 16; ++j) { const unsigned c = xb_ld(&bar[XB_XCNT(j)]); sum += c; cnt += (c > 0u) ? 1u : 0u; mine = (j == x) ? c : mine; }
      if (sum == G) break;
      __builtin_amdgcn_s_sleep(1);
      if ((++sp & 255u) == 0u) { if (xb_ld(&bar[XB_TMO])) break; if (sp > XB_SPIN_CAP) { atomicAdd(&bar[XB_TMO], 1u); break; } }
    }
    st[0] = mine > 0u ? mine : 1u; st[1] = cnt > 0u ? cnt : 1u; st[2] = x;
  }
  __syncthreads();
}

__global__ void __launch_bounds__(NTHR, 2) mega_kernel(Params p) {
  extern __shared__ __attribute__((aligned(16))) unsigned char smraw[];
  int* sItem = (int*)(smraw + STAGE_BYTES);
  cg::grid_group grid = cg::this_grid();
  volatile unsigned* xst = (volatile unsigned*)(smraw + STAGE_BYTES + 16);
  if (blockIdx.x == 0) for (int i = threadIdx.x; i < 4096; i += NTHR) p.ctr[i] = 0u;
  grid.sync();
  if (threadIdx.x == 0) (void)xb_add(&p.ctr[XB_XCNT(xb_xcc_id())], 1u);
#define DO_PHASE(K) if (p.p0 <= (K) && (K) < p.p1) { run_phase(p, (K), smraw, sItem); if ((K) + 1 < p.p1) { if ((K) == 0) xb_setup(p.ctr, xst); xcd_barrier(p.ctr, xst); } }
  DO_PHASE(0) DO_PHASE(1) DO_PHASE(2) DO_PHASE(3) DO_PHASE(4) DO_PHASE(5)
  DO_PHASE(6) DO_PHASE(7) DO_PHASE(8) DO_PHASE(9) DO_PHASE(10) DO_PHASE(11)
}

extern "C" void kernel_launch(void* const* d_in, const int* in_sizes, int n_in, void* d_out, int out_size,
                              void* d_ws, size_t ws_size, hipStream_t stream) {
  static int grid_blocks = 0;
  if (!grid_blocks) {
    int dev = 0, cus = 0, per_cu = 0;
    (void)hipGetDevice(&dev);
    (void)hipDeviceGetAttribute(&cus, hipDeviceAttributeMultiprocessorCount, dev);
    if (hipFuncSetAttribute((const void*)mega_kernel, hipFuncAttributeMaxDynamicSharedMemorySize, LDS_BYTES) != hipSuccess)
      fprintf(stderr, "kernel_launch: hipFuncSetAttribute failed\n");
    (void)hipOccupancyMaxActiveBlocksPerMultiprocessor(&per_cu, (const void*)mega_kernel, NTHR, LDS_BYTES);
    if (per_cu < 1) fprintf(stderr, "kernel_launch: occupancy query says %d blocks/CU\n", per_cu);
    (void)hipGetLastError();
    grid_blocks = cus > 0 ? cus : 256;
  }
  Params p;
  memset(&p, 0, sizeof(p));
  const float* const* in = (const float* const*)d_in;
  p.x_prompt = in[0]; p.x_sample = in[1]; p.cache_ckv = in[2]; p.cache_krope = in[3]; p.state_hgrn = in[4];
  p.c_prompt = in[5]; p.c_sample = in[6]; p.w_in = in[7]; p.q_norm = in[8]; p.w_uq = in[9]; p.kv_norm = in[10];
  p.w_ukv = in[11]; p.lb_param = in[12]; p.hg_norm = in[13]; p.w_pa = in[14]; p.w_pb = in[15]; p.w_out = in[16];
  p.norm1 = in[17]; p.norm2 = in[18]; p.w_ada = in[19]; p.b_ada = in[20]; p.w_gu = in[21]; p.w_down = in[22];
  p.final_norm = in[23];
  p.out = (float*)d_out;
  unsigned char* ws = (unsigned char*)d_ws;
  size_t off = 0;
  auto take = [&](size_t bytes) { unsigned char* r = ws + off; off += (bytes + 255) & ~(size_t)255; return r; };
  p.wt_in = (u16*)take((size_t)4864 * 1024 * 2);
  p.wt_uq = (u16*)take((size_t)768 * 384 * 2);
  p.wt_ukv = (u16*)take((size_t)1024 * 256 * 2);
  p.wt_pa = (u16*)take((size_t)1024 * 512 * 2);
  p.wt_pb = (u16*)take((size_t)1024 * 512 * 2);
  p.wt_out = (u16*)take((size_t)1024 * 1024 * 2);
  p.wt_gu = (u16*)take((size_t)5632 * 1024 * 2);
  p.wt_dn = (u16*)take((size_t)1024 * 2816 * 2);
  p.mod = (float*)take((size_t)34 * 6144 * 4);
  p.tab = (float*)take((size_t)TSEQ * 32 * 4);
  p.ctr = (unsigned*)take(16384);
  p.DEC = (float*)take((size_t)512 * 128 * 4);
  p.HS = (float*)take((size_t)512 * 16384 * 4);
  p.Z = (u16*)take((size_t)NT * LDZ * 2);
  unsigned char* regS = ws + off;
  p.H = (u16*)regS;
  p.KNs = (u16*)regS;
  p.VTs = p.KNs + (size_t)32 * SKV * 512;
  p.KRs = p.VTs + (size_t)32 * 512 * SKV;
  off += (size_t)32 * SKV * 512 * 2 * 2 + (size_t)32 * SKV * 32 * 2;
  if (off > ws_size) { fprintf(stderr, "kernel_launch: workspace too small: need %zu have %zu\n", off, ws_size); return; }
  p.H1 = (u16*)d_out;
  p.Q = (u16*)d_out;
  p.KNp = p.Q + (size_t)NT * 768;
  p.VTp = p.KNp + (size_t)NP * 512;
  p.CKVb = (u16*)((float*)d_out + O_CKVP);
  p.p0 = 0; p.p1 = NPHASE;
  void* args[] = {&p};
  hipError_t e = hipLaunchCooperativeKernel((void*)mega_kernel, dim3(grid_blocks), dim3(NTHR), args, LDS_BYTES, stream);
  if (e != hipSuccess) fprintf(stderr, "cooperative launch failed: %s (grid %d)\n", hipGetErrorString(e), grid_blocks);
}
```

```cpp
#include <hip/hip_runtime.h>
#include <hip/hip_cooperative_groups.h>
#include <cstdio>
#include <cstring>
namespace cg = cooperative_groups;

typedef unsigned short u16;
typedef __attribute__((ext_vector_type(8))) short bf16x8;
typedef __attribute__((ext_vector_type(4))) float f32x4;
typedef __attribute__((ext_vector_type(2))) float f32x2;
typedef __attribute__((ext_vector_type(4))) unsigned u32x4;
typedef __attribute__((ext_vector_type(2))) unsigned u32x2;
#define LAS __attribute__((address_space(3)))

#define NTHR 512
#define NP 32768
#define NS 512
#define NT 33280
#define LDZ 4768
#define ZKV 384
#define ZKR 640
#define ZHQ 672
#define ZHF 1184
#define ZHI 1696
#define ZHG 2208
#define ZGA 2720
#define ZGB 3744
#define SKV 2112
#define TSEQ 16384
#define NPHASE 12

#define O_Y 0
#define O_CKVP 34078720
#define O_KRP 42467328
#define O_HSP 43515904
#define O_CKVS 43646976
#define O_KRS 43778048
#define O_HSS 43794432

#define STAGE_BYTES 131072
#define LDS_BYTES (STAGE_BYTES + 256)
#define HG_LDS 44032

struct Params {
  const float *x_prompt, *x_sample, *cache_ckv, *cache_krope, *state_hgrn, *c_prompt, *c_sample;
  const float *w_in, *q_norm, *w_uq, *kv_norm, *w_ukv, *lb_param, *hg_norm, *w_pa, *w_pb, *w_out;
  const float *norm1, *norm2, *w_ada, *b_ada, *w_gu, *w_down, *final_norm;
  float* out;
  u16 *wt_in, *wt_uq, *wt_ukv, *wt_pa, *wt_pb, *wt_out, *wt_gu, *wt_dn;
  float* mod; float* tab;
  u16* H; u16 *KNs, *VTs, *KRs; u16* Z; float* HS; float* DEC;
  u16 *Q, *KNp, *VTp; u16* H1; u16* CKVb;
  unsigned* ctr;
  int p0, p1;
};

__device__ __forceinline__ bf16x8 mk8(unsigned a, unsigned b, unsigned c, unsigned d) { u32x4 t = {a, b, c, d}; return __builtin_bit_cast(bf16x8, t); }
__device__ __forceinline__ bf16x8 cat8(u32x2 lo, u32x2 hi) { u32x4 t = {lo.x, lo.y, hi.x, hi.y}; return __builtin_bit_cast(bf16x8, t); }

typedef __attribute__((ext_vector_type(2))) __bf16 bf16x2_t;
__device__ __forceinline__ unsigned pack2(float a, float b) { const f32x2 v = {a, b}; return __builtin_bit_cast(unsigned, __builtin_convertvector(v, bf16x2_t)); }
__device__ __forceinline__ u16 f2bf(float f) { return (u16)(pack2(f, f) & 0xffffu); }
__device__ __forceinline__ float bf2f(u16 h) { return __uint_as_float(((unsigned)h) << 16); }
__device__ __forceinline__ float bflo(unsigned u) { return __uint_as_float(u << 16); }
__device__ __forceinline__ float bfhi(unsigned u) { return __uint_as_float(u & 0xffff0000u); }
__device__ __forceinline__ float frcp(float x) { return __builtin_amdgcn_rcpf(x); }
__device__ __forceinline__ float sigmoidf_(float x) { return frcp(1.0f + __expf(-x)); }
__device__ __forceinline__ float siluf_(float x) { return x * frcp(1.0f + __expf(-x)); }
__device__ __forceinline__ float wave_sum(float v) {
#pragma unroll
  for (int o = 32; o > 0; o >>= 1) v += __shfl_xor(v, o);
  return v;
}
__device__ __forceinline__ int otid() { int t = threadIdx.x; asm volatile("" : "+v"(t)); return t; }
__device__ __forceinline__ int obid() { int b = blockIdx.x; asm volatile("" : "+s"(b)); return b; }
#define EXP2(x) __builtin_amdgcn_exp2f(x)
__device__ __forceinline__ float max_x32(float x) { const unsigned u = __float_as_uint(x); auto r = __builtin_amdgcn_permlane32_swap(u, u, false, false); return fmaxf(__uint_as_float(r[0]), __uint_as_float(r[1])); }
__device__ __forceinline__ float max_x16(float x) { const unsigned u = __float_as_uint(x); auto r = __builtin_amdgcn_permlane16_swap(u, u, false, false); return fmaxf(__uint_as_float(r[0]), __uint_as_float(r[1])); }
#define MFMA(a, b, c) __builtin_amdgcn_mfma_f32_16x16x32_bf16((a), (b), (c), 0, 0, 0)

#define XB_TMO      128
#define XB_XCNT(j)  (256  + 64 * (j))
#define XB_XSUB(j)  (1280 + 64 * (j))
#define XB_XGEN(j)  (2304 + 64 * (j))
#define XB_TOP      3328
#define XB_TOPGEN   3392
#define XB_SPIN_CAP (1u << 22)
__device__ __forceinline__ unsigned xb_ld(unsigned* p)              { return __hip_atomic_load(p, __ATOMIC_RELAXED, __HIP_MEMORY_SCOPE_AGENT); }
__device__ __forceinline__ unsigned xb_add(unsigned* p, unsigned v) { return __hip_atomic_fetch_add(p, v, __ATOMIC_RELAXED, __HIP_MEMORY_SCOPE_AGENT); }
__device__ __forceinline__ unsigned xb_xcc_id() { return (unsigned)__builtin_amdgcn_s_getreg((3 << 11) | 20) & 0xFu; }
#define XB_SPIN(cond, bar) do { unsigned _sp = 0; while (cond) { __builtin_amdgcn_s_sleep(1); \
    if ((++_sp & 255u) == 0u) { if (xb_ld(&(bar)[XB_TMO])) break; if (_sp > XB_SPIN_CAP) { atomicAdd(&(bar)[XB_TMO], 1u); break; } } } } while (0)
__device__ __forceinline__ void xcd_barrier(unsigned* bar, volatile unsigned* st  ) {
  asm volatile("s_waitcnt vmcnt(0)" ::: "memory");
  __syncthreads();
  if (threadIdx.x == 0) {
    __builtin_amdgcn_s_waitcnt(0);
    const unsigned nloc = st[0], nx = st[1], x = st[2];
    const unsigned old = xb_add(&bar[XB_XSUB(x)], 1u);
    const unsigned gen = old / nloc;
    if (old + 1u == (gen + 1u) * nloc) {
      __builtin_amdgcn_fence(__ATOMIC_RELEASE, "agent");
      asm volatile("s_waitcnt vmcnt(0)" ::: "memory");
      const unsigned og = xb_add(&bar[XB_TOP], 1u);
      const unsigned tg = og / nx;
      if (og + 1u == (tg + 1u) * nx) xb_add(&bar[XB_TOPGEN], 1u);
      else XB_SPIN(xb_ld(&bar[XB_TOPGEN]) == tg, bar);
      __builtin_amdgcn_fence(__ATOMIC_ACQUIRE, "agent");
      xb_add(&bar[XB_XGEN(x)], 1u);
      asm volatile("s_waitcnt vmcnt(0)" ::: "memory");
    } else {
      XB_SPIN(xb_ld(&bar[XB_XGEN(x)]) == gen, bar);
      __builtin_amdgcn_fence(__ATOMIC_ACQUIRE, "agent");
      asm volatile("s_waitcnt vmcnt(0)" ::: "memory");
    }
  }
  __syncthreads();
}

__device__ __forceinline__ int bidx_of(int row) { return row < NP ? (row >> 14) : 2 + ((row - NP) >> 4); }
__device__ __forceinline__ int pos_of(int row) { return row < NP ? (row & (TSEQ - 1)) : 2048 + ((row - NP) & 15); }

__device__ __forceinline__ void transpose_w(const float* __restrict__ src, u16* __restrict__ dst, int K, int N, int mode, float* tile) {
  const int tid = otid();
  const int nkt = K >> 7, nnt = N >> 5, T = nkt * nnt;
  for (int t = obid(); t < T; t += gridDim.x) {
    const int kt = t % nkt, ntile = t / nkt;
    __syncthreads();
#pragma unroll
    for (int ps = 0; ps < 2; ++ps) {
      const int k = (tid >> 3) + 64 * ps, n4 = (tid & 7) * 4;
      const f32x4 v = *(const f32x4*)(src + (size_t)(kt * 128 + k) * N + ntile * 32 + n4);
      tile[k * 33 + n4 + 0] = v.x; tile[k * 33 + n4 + 1] = v.y; tile[k * 33 + n4 + 2] = v.z; tile[k * 33 + n4 + 3] = v.w;
    }
    __syncthreads();
    {
      const int nl = tid >> 4, kc = tid & 15, n = ntile * 32 + nl;
      float f[8];
#pragma unroll
      for (int i = 0; i < 8; ++i) f[i] = tile[(kc * 8 + i) * 33 + nl];
      int R = n;
      if (mode == 1) R = n < 2816 ? ((n >> 4) * 32 + (n & 15)) : (((n - 2816) >> 4) * 32 + 16 + ((n - 2816) & 15));
      u32x4 o = {pack2(f[0], f[1]), pack2(f[2], f[3]), pack2(f[4], f[5]), pack2(f[6], f[7])};
      *(u32x4*)(dst + (size_t)R * K + kt * 128 + kc * 8) = o;
    }
  }
}

__device__ __forceinline__ void adaln(const Params& p, float* sm) {
  const int tid = otid(), lane = tid & 63, w = tid >> 6;
  for (int it = obid(); it < 96; it += gridDim.x) {
    const int col = it * 64 + lane;
    float acc[34];
#pragma unroll
    for (int b = 0; b < 34; ++b) acc[b] = 0.f;
    float* sC = sm + w * (64 * 36);
    for (int kc = 0; kc < 2; ++kc) {
      const int kb = w * 128 + kc * 64;
      __syncthreads();
#pragma unroll
      for (int b = 0; b < 34; ++b) {
        const float* cr = b < 2 ? p.c_prompt + b * 1024 : p.c_sample + (b - 2) * 1024;
        float c = cr[kb + lane];
        sC[lane * 36 + b] = siluf_(c);
      }
      __syncthreads();
#pragma unroll 8
      for (int kk = 0; kk < 64; ++kk) {
        float wv = p.w_ada[(size_t)(kb + kk) * 6144 + col];
#pragma unroll
        for (int b4 = 0; b4 < 8; ++b4) {
          f32x4 s = *(const f32x4*)&sC[kk * 36 + b4 * 4];
          acc[b4 * 4 + 0] += s.x * wv; acc[b4 * 4 + 1] += s.y * wv; acc[b4 * 4 + 2] += s.z * wv; acc[b4 * 4 + 3] += s.w * wv;
        }
        f32x2 s2 = *(const f32x2*)&sC[kk * 36 + 32];
        acc[32] += s2.x * wv; acc[33] += s2.y * wv;
      }
    }
    __syncthreads();
    float* red = sm;
#pragma unroll
    for (int b = 0; b < 34; ++b) red[(w * 34 + b) * 64 + lane] = acc[b];
    __syncthreads();
    for (int idx = tid; idx < 34 * 64; idx += NTHR) {
      int b = idx >> 6, c = idx & 63;
      float s = 0.f;
#pragma unroll
      for (int ww = 0; ww < 8; ++ww) s += red[(ww * 34 + b) * 64 + c];
      p.mod[b * 6144 + it * 64 + c] = s + p.b_ada[it * 64 + c];
    }
    __syncthreads();
  }
}

__device__ __forceinline__ void phase0(const Params& p, unsigned char* smraw) {
  float* smf = (float*)smraw;
  const int tid = otid();
  adaln(p, smf);
  transpose_w(p.w_in, p.wt_in, 1024, 4768, 0, smf);
  transpose_w(p.w_gu, p.wt_gu, 1024, 5632, 1, smf);
  transpose_w(p.w_down, p.wt_dn, 2816, 1024, 0, smf);
  transpose_w(p.w_out, p.wt_out, 1024, 1024, 0, smf);
  transpose_w(p.w_pa, p.wt_pa, 512, 1024, 0, smf);
  transpose_w(p.w_pb, p.wt_pb, 512, 1024, 0, smf);
  transpose_w(p.w_uq, p.wt_uq, 384, 768, 0, smf);
  transpose_w(p.w_ukv, p.wt_ukv, 256, 1024, 0, smf);
  const size_t gt = (size_t)obid() * NTHR + tid, gn = (size_t)gridDim.x * NTHR;
  for (size_t i = gt; i < (size_t)96 * 1024 / 8; i += gn) *(u32x4*)(p.wt_in + (size_t)4768 * 1024 + i * 8) = (u32x4){0u, 0u, 0u, 0u};
  {
    const int nb = (int)gridDim.x, skip = nb > 96 ? 96 : 0;
    if (obid() >= skip) {
      const size_t ct = (size_t)(obid() - skip) * NTHR + tid, cn = (size_t)(nb - skip) * NTHR;
      for (size_t i = ct; i < (size_t)65536 * 256 / 8; i += cn) {
        const f32x4 a = *(const f32x4*)(p.cache_ckv + i * 8), b = *(const f32x4*)(p.cache_ckv + i * 8 + 4);
        u32x4 o = {pack2(a.x, a.y), pack2(a.z, a.w), pack2(b.x, b.y), pack2(b.z, b.w)};
        *(u32x4*)(p.CKVb + i * 8) = o;
      }
    }
  }
  for (size_t i = gt; i < (size_t)TSEQ * 16; i += gn) {
    const int pos = (int)(i >> 4), j = (int)(i & 15);
    const int jm = j & 3, jd = j >> 2;
    double inv = jm == 0 ? 1.0 : (jm == 1 ? 0.5623413251903491 : (jm == 2 ? 0.31622776601683794 : 0.1778279410038923));
    inv *= (jd == 0 ? 1.0 : (jd == 1 ? 0.1 : (jd == 2 ? 0.01 : 0.001)));
    const double a = (double)pos * inv;
    const double k = rint(a * 0.15915494309189535);
    double r = fma(-k, 6.283185307179586, a);
    r = fma(-k, 2.4492935982947064e-16, r);
    const double r2 = r * r;
    double c = 1.0, s = r, tc = 1.0, ts = r;
#pragma unroll 1
    for (int n = 1; n <= 16; ++n) {
      tc *= -r2 / (double)((2 * n - 1) * (2 * n));
      ts *= -r2 / (double)((2 * n) * (2 * n + 1));
      c += tc; s += ts;
    }
    p.tab[pos * 32 + j] = (float)c;
    p.tab[pos * 32 + 16 + j] = (float)s;
  }
  for (size_t i = gt; i < (size_t)32 * SKV * 32; i += gn) {
    int d = (int)(i & 31); size_t r = i >> 5; int s = (int)(r % SKV); int b = (int)(r / SKV);
    if (s < 2048) p.KRs[i] = f2bf(p.cache_krope[((size_t)b * 2048 + s) * 32 + d]);
    else if (s >= 2064) p.KRs[i] = 0;
  }
  for (size_t i = gt; i < (size_t)32 * 48 * 512; i += gn) {
    int c = (int)(i & 511); size_t r = i >> 9; int s = (int)(r % 48); int b = (int)(r / 48);
    p.KNs[((size_t)b * SKV + 2064 + s) * 512 + c] = 0;
  }
  for (size_t i = gt; i < (size_t)32 * 512 * 48; i += gn) {
    int s = (int)(i % 48); size_t r = i / 48;
    p.VTs[r * SKV + 2064 + s] = 0;
  }
}

#define NR 4
__device__ __forceinline__ void norm_mod(const Params& p, int which) {
  const int tid = otid(), lane = tid & 63, w = tid >> 6;
  const float* nwp = which ? p.norm2 : p.norm1;
  u16* dst = which ? p.H : p.H1;
  for (int row0 = (obid() * 8 + w) * NR; row0 < NT; row0 += gridDim.x * 8 * NR) {
    const float* xr = which ? p.out + (size_t)row0 * 1024
                            : (row0 < NP ? p.x_prompt + (size_t)row0 * 1024 : p.x_sample + (size_t)(row0 - NP) * 1024);
    f32x4 v[NR][4]; float ss[NR];
#pragma unroll
    for (int r = 0; r < NR; ++r)
#pragma unroll
      for (int i = 0; i < 4; ++i) v[r][i] = __builtin_nontemporal_load((const f32x4*)(xr + r * 1024 + i * 256 + lane * 4));
#pragma unroll
    for (int r = 0; r < NR; ++r) {
      ss[r] = 0.f;
#pragma unroll
      for (int i = 0; i < 4; ++i) ss[r] += v[r][i].x * v[r][i].x + v[r][i].y * v[r][i].y + v[r][i].z * v[r][i].z + v[r][i].w * v[r][i].w;
    }
#pragma unroll
    for (int o = 32; o > 0; o >>= 1) {
#pragma unroll
      for (int r = 0; r < NR; ++r) ss[r] += __shfl_xor(ss[r], o);
    }
    const float* md = p.mod + bidx_of(row0) * 6144 + (which ? 3072 : 0);
#pragma unroll
    for (int i = 0; i < 4; ++i) {
      const int col = i * 256 + lane * 4;
      const f32x4 nw = *(const f32x4*)(nwp + col), sh = *(const f32x4*)(md + col), sc = *(const f32x4*)(md + 1024 + col);
#pragma unroll
      for (int r = 0; r < NR; ++r) {
        const float rstd = rsqrtf(ss[r] * (1.0f / 1024.0f) + 1e-6f);
        float h0 = v[r][i].x * rstd * nw.x * (1.f + sc.x) + sh.x;
        float h1 = v[r][i].y * rstd * nw.y * (1.f + sc.y) + sh.y;
        float h2 = v[r][i].z * rstd * nw.z * (1.f + sc.z) + sh.z;
        float h3 = v[r][i].w * rstd * nw.w * (1.f + sc.w) + sh.w;
        u32x2 o; o.x = pack2(h0, h1); o.y = pack2(h2, h3);
        *(u32x2*)(dst + (size_t)(row0 + r) * 1024 + col) = o;
      }
    }
  }
}

__device__ __forceinline__ void final_norm(const Params& p) {
  const int tid = otid(), lane = tid & 63, w = tid >> 6;
  for (int row0 = (obid() * 8 + w) * NR; row0 < NT; row0 += gridDim.x * 8 * NR) {
    float* xr = p.out + (size_t)row0 * 1024;
    f32x4 v[NR][4]; float ss[NR];
#pragma unroll
    for (int r = 0; r < NR; ++r)
#pragma unroll
      for (int i = 0; i < 4; ++i) v[r][i] = __builtin_nontemporal_load((const f32x4*)(xr + r * 1024 + i * 256 + lane * 4));
#pragma unroll
    for (int r = 0; r < NR; ++r) {
      ss[r] = 0.f;
#pragma unroll
      for (int i = 0; i < 4; ++i) ss[r] += v[r][i].x * v[r][i].x + v[r][i].y * v[r][i].y + v[r][i].z * v[r][i].z + v[r][i].w * v[r][i].w;
    }
#pragma unroll
    for (int o = 32; o > 0; o >>= 1) {
#pragma unroll
      for (int r = 0; r < NR; ++r) ss[r] += __shfl_xor(ss[r], o);
    }
#pragma unroll
    for (int i = 0; i < 4; ++i) {
      const int col = i * 256 + lane * 4;
      const f32x4 nw = *(const f32x4*)(p.final_norm + col);
#pragma unroll
      for (int r = 0; r < NR; ++r) {
        const float rstd = rsqrtf(ss[r] * (1.0f / 1024.0f) + 1e-6f);
        f32x4 o; o.x = v[r][i].x * rstd * nw.x; o.y = v[r][i].y * rstd * nw.y; o.z = v[r][i].z * rstd * nw.z; o.w = v[r][i].w * rstd * nw.w;
        __builtin_nontemporal_store(o, (f32x4*)(xr + r * 1024 + col));
      }
    }
  }
}

__device__ __forceinline__ void rowpost(const Params& p) {
  const int tid = otid(), lane = tid & 63, w = tid >> 6;
  for (int row0 = (obid() * 8 + w) * 2; row0 < NT; row0 += gridDim.x * 16) {
    u16 rq[2][6], rk[2][4], rx1[2], rx2[2]; float cs[2], sn[2];
#pragma unroll
    for (int r = 0; r < 2; ++r) {
      const u16* z = p.Z + (size_t)(row0 + r) * LDZ;
#pragma unroll
      for (int i = 0; i < 6; ++i) rq[r][i] = z[i * 64 + lane];
#pragma unroll
      for (int i = 0; i < 4; ++i) rk[r][i] = z[ZKV + i * 64 + lane];
      rx1[r] = z[ZKR + (lane & 15)]; rx2[r] = z[ZKR + 16 + (lane & 15)];
      const int pos = pos_of(row0 + r);
      cs[r] = p.tab[pos * 32 + (lane & 15)]; sn[r] = p.tab[pos * 32 + 16 + (lane & 15)];
    }
    float qn[6], kn[4];
#pragma unroll
    for (int i = 0; i < 6; ++i) qn[i] = p.q_norm[i * 64 + lane];
#pragma unroll
    for (int i = 0; i < 4; ++i) kn[i] = p.kv_norm[i * 64 + lane];
#pragma unroll
    for (int r = 0; r < 2; ++r) {
      const int row = row0 + r;
      u16* z = p.Z + (size_t)row * LDZ;
      float q[6], k[4]; float sq = 0.f, sk = 0.f;
#pragma unroll
      for (int i = 0; i < 6; ++i) { q[i] = bf2f(rq[r][i]); sq += q[i] * q[i]; }
#pragma unroll
      for (int i = 0; i < 4; ++i) { k[i] = bf2f(rk[r][i]); sk += k[i] * k[i]; }
#pragma unroll
      for (int o = 32; o > 0; o >>= 1) { sq += __shfl_xor(sq, o); sk += __shfl_xor(sk, o); }
      const float rq_ = rsqrtf(sq * (1.0f / 384.0f) + 1e-6f), rk_ = rsqrtf(sk * (1.0f / 256.0f) + 1e-6f);
#pragma unroll
      for (int i = 0; i < 6; ++i) z[i * 64 + lane] = f2bf(q[i] * rq_ * qn[i]);
      float* o = row < NP ? p.out + O_CKVP + (size_t)row * 256 : p.out + O_CKVS + (size_t)(row - NP) * 256;
#pragma unroll
      for (int i = 0; i < 4; ++i) {
        const float c = k[i] * rk_ * kn[i];
        o[i * 64 + lane] = c;
        z[ZKV + i * 64 + lane] = f2bf(c);
      }
      if (lane < 16) {
        const float x1 = bf2f(rx1[r]), x2 = bf2f(rx2[r]);
        const float o1 = x1 * cs[r] - x2 * sn[r], o2 = x1 * sn[r] + x2 * cs[r];
        if (row < NP) {
          float* ko = p.out + O_KRP + (size_t)row * 32;
          ko[lane] = o1; ko[16 + lane] = o2;
          z[ZKR + lane] = f2bf(o1); z[ZKR + 16 + lane] = f2bf(o2);
        } else {
          float* ko = p.out + O_KRS + (size_t)(row - NP) * 32;
          ko[lane] = o1; ko[16 + lane] = o2;
          const int bs = (row - NP) >> 4, t = (row - NP) & 15;
          u16* kr = p.KRs + ((size_t)bs * SKV + 2048 + t) * 32;
          kr[lane] = f2bf(o1); kr[16 + lane] = f2bf(o2);
        }
      }
    }
  }
}

namespace pg8 {
constexpr int BM = 256, BK = 64, HALF = 128, HTB = HALF * BK * 2, NXCD = 8, WGM = 8;
__device__ __forceinline__ int lds_byte(int r, int c) { const int st = (r >> 4) * 2 + (c >> 5), rr = r & 15, cc = c & 31, ob = rr * 64 + cc * 2; return st * 1024 + (ob ^ (((ob >> 9) & 1) << 5)); }
__device__ __forceinline__ void stage_rc(int b, int& R, int& C) { const int st = b / 1024, sb = b % 1024, swz = sb ^ (((sb >> 9) & 1) << 5); R = (st >> 1) * 16 + swz / 64; C = (st & 1) * 32 + (swz % 64) / 2; }
struct Unit { int pm, pn; };
struct Gemm { const u16* A; int lda; const u16* Bt; int K, nM, nN; };
struct StaticOrder {
  int nM, nN, nwg, G, c;
  __device__ __forceinline__ void init(int nM_, int nN_, int G_, int c_) { nM = nM_; nN = nN_; nwg = nM * nN; G = G_; c = c_; }
  __device__ __forceinline__ bool next(int i, Unit& u) const {
    const long L = (long)i * G + c; if (L >= nwg) return false;
    int wgid = (int)L; { const int q = nwg / NXCD, r = nwg % NXCD, xcd = wgid % NXCD, off = wgid / NXCD; wgid = (xcd < r ? xcd * (q + 1) : r * (q + 1) + (xcd - r) * q) + off; }
    const int nig = WGM * nN, gid = wgid / nig, fm = gid * WGM, gsz = (nM - fm) < WGM ? (nM - fm) : WGM;
    u.pm = fm + ((wgid % nig) % gsz); u.pn = (wgid % nig) / gsz; return true;
  }
};

template <class Epi>
__device__ __forceinline__ void gemm_phase(LAS unsigned char* lds, const Gemm g, const Epi& E) {
  const int tid = otid(), wid = __builtin_amdgcn_readfirstlane(tid >> 6), lane = tid & 63, wr = wid >> 2, wc = wid & 3, fr = lane & 15, fq = lane >> 4;
  int K_ = g.K; asm volatile("" : "+s"(K_));
  const int K = K_, nt = K / BK;
  StaticOrder S; S.init(g.nM, g.nN, (int)gridDim.x, obid());
  unsigned voffA[2], voffB[2];
#pragma unroll
  for (int i = 0; i < 2; ++i) { int R, C; stage_rc(tid * 16 + i * 8192, R, C);
    voffA[i] = (unsigned)(R * g.lda + C) * 2u; voffB[i] = (unsigned)(R * K + C) * 2u; }
  const size_t kstep = (size_t)(BK * 2);
  const size_t hstepA = (size_t)HALF * g.lda * 2, hstepB = (size_t)HALF * K * 2;
  const size_t tstepA = 2 * hstepA, tstepB = 2 * hstepB;
  const unsigned ldsw = (unsigned)wid * 1024u;
  const int aoff = lds_byte(wr * 64 + fr, fq * 8), boff = lds_byte(wc * 32 + fr, fq * 8);
#define PG8_SA(b, h) (((b) * 2 + (h)) * HTB)
#define PG8_SB(b, h) ((4 + (b) * 2 + (h)) * HTB)
#define PG8_STAGE(bufoff, gbase, voff) do { _Pragma("unroll") for (int _i = 0; _i < 2; ++_i) \
        __builtin_amdgcn_global_load_lds((const unsigned*)((const char*)(gbase) + (voff)[_i]), (LAS unsigned*)(lds + (bufoff) + ldsw + _i * 8192), 16, 0, 0); } while (0)
#define PG8_LDA(dst, b, h) do { _Pragma("unroll") for (int m = 0; m < 4; ++m) _Pragma("unroll") for (int k = 0; k < 2; ++k) dst[m][k] = *(const LAS bf16x8*)(lds + PG8_SA(b, h) + aoff + m * 2048 + k * 1024); } while (0)
#define PG8_LDB(dst, b, h) do { _Pragma("unroll") for (int n = 0; n < 2; ++n) _Pragma("unroll") for (int k = 0; k < 2; ++k) dst[n][k] = *(const LAS bf16x8*)(lds + PG8_SB(b, h) + boff + n * 2048 + k * 1024); } while (0)
#define PG8_MMA(ai, bj, At, Bt) do { __builtin_amdgcn_s_setprio(1); _Pragma("unroll") for (int m = 0; m < 4; ++m) _Pragma("unroll") for (int n = 0; n < 2; ++n) _Pragma("unroll") for (int k = 0; k < 2; ++k) \
        acc[ai][bj][m][n] = __builtin_amdgcn_mfma_f32_16x16x32_bf16(Bt[n][k], At[m][k], acc[ai][bj][m][n], 0, 0, 0); __builtin_amdgcn_s_setprio(0); } while (0)
#define PG8_WAIT_V(n) asm volatile("s_waitcnt vmcnt(" #n ")" ::: "memory")
#define PG8_WAIT_L(n) asm volatile("s_waitcnt lgkmcnt(" #n ")" ::: "memory")
#define PG8_BAR __builtin_amdgcn_s_barrier()
#define PG8_SCHED __builtin_amdgcn_sched_barrier(0)
  Unit cur, nxt; int ui = 0;
  if (!S.next(0, cur)) return;
  f32x4 acc[2][2][4][2];
#pragma unroll
  for (int a = 0; a < 2; ++a)
#pragma unroll
    for (int b = 0; b < 2; ++b)
#pragma unroll
      for (int m = 0; m < 4; ++m)
#pragma unroll
        for (int n = 0; n < 2; ++n) acc[a][b][m][n] = (f32x4){0.f, 0.f, 0.f, 0.f};
  bf16x8 At[4][2], B0[2][2], B1[2][2];
  const char* cA = (const char*)g.A + (size_t)cur.pm * tstepA; const char* cB = (const char*)g.Bt + (size_t)cur.pn * tstepB;
  PG8_WAIT_V(0);
  PG8_STAGE(PG8_SB(0, 0), cB, voffB); PG8_STAGE(PG8_SA(0, 0), cA, voffA); PG8_STAGE(PG8_SB(0, 1), cB + hstepB, voffB); PG8_STAGE(PG8_SA(0, 1), cA + hstepA, voffA);
  if (wr == 1) PG8_BAR;
  PG8_WAIT_V(4); PG8_BAR;
  PG8_STAGE(PG8_SB(1, 0), cB + kstep, voffB); PG8_STAGE(PG8_SA(1, 0), cA + kstep, voffA); PG8_STAGE(PG8_SB(1, 1), cB + hstepB + kstep, voffB);
  PG8_WAIT_V(6); PG8_BAR;
  for (;;) {
    const bool has_next = S.next(ui + 1, nxt);
    const char* nA = has_next ? (const char*)g.A + (size_t)nxt.pm * tstepA : cA; const char* nB = has_next ? (const char*)g.Bt + (size_t)nxt.pn * tstepB : cB;
#pragma unroll 1
    for (int t = 0; t < nt; t += 2) {
      const bool last = (t == nt - 2);
      const char* a1 = cA + (size_t)(t + 1) * kstep;
      const char* a2 = last ? nA : cA + (size_t)(t + 2) * kstep; const char* b2 = last ? nB : cB + (size_t)(t + 2) * kstep;
      const char* a3 = a2 + kstep; const char* b3 = b2 + kstep;
      PG8_LDB(B0, 0, 0); PG8_SCHED; PG8_LDA(At, 0, 0); PG8_STAGE(PG8_SA(1, 1), a1 + hstepA, voffA);
      PG8_WAIT_L(8); PG8_BAR; PG8_WAIT_L(0); PG8_MMA(0, 0, At, B0); PG8_BAR; PG8_SCHED;
      PG8_LDB(B1, 0, 1); PG8_STAGE(PG8_SB(0, 0), b2, voffB);
      PG8_BAR; PG8_WAIT_L(0); PG8_MMA(0, 1, At, B1); PG8_BAR;
      PG8_LDA(At, 0, 1); PG8_STAGE(PG8_SA(0, 0), a2, voffA);
      PG8_BAR; PG8_WAIT_L(0); PG8_MMA(1, 0, At, B0); PG8_BAR; PG8_SCHED;
      PG8_STAGE(PG8_SB(0, 1), b2 + hstepB, voffB);
      PG8_WAIT_V(6); PG8_BAR; PG8_MMA(1, 1, At, B1); PG8_BAR;
      PG8_LDB(B0, 1, 0); PG8_SCHED; PG8_LDA(At, 1, 0); PG8_STAGE(PG8_SA(0, 1), a2 + hstepA, voffA);
      PG8_WAIT_L(8); PG8_BAR; PG8_WAIT_L(0); PG8_MMA(0, 0, At, B0); PG8_BAR; PG8_SCHED;
      PG8_LDB(B1, 1, 1); PG8_STAGE(PG8_SB(1, 0), b3, voffB);
      PG8_BAR; PG8_WAIT_L(0); PG8_MMA(0, 1, At, B1); PG8_BAR;
      PG8_LDA(At, 1, 1); PG8_STAGE(PG8_SA(1, 0), a3, voffA);
      PG8_BAR; PG8_WAIT_L(0); PG8_MMA(1, 0, At, B0); PG8_BAR; PG8_SCHED;
      PG8_STAGE(PG8_SB(1, 1), b3 + hstepB, voffB);
      PG8_WAIT_V(6); PG8_BAR; PG8_MMA(1, 1, At, B1); PG8_BAR;
    }
    {
      const int rowb = cur.pm * BM + wr * 64 + fr, colb = cur.pn * BM + wc * 32 + fq * 4;
      const typename Epi::UPre up = E.uload(rowb, colb);
#pragma unroll
      for (int ai = 0; ai < 2; ++ai) {
        typename Epi::Pre pre[4][2];
#pragma unroll
        for (int m = 0; m < 4; ++m)
#pragma unroll
          for (int bj = 0; bj < 2; ++bj) pre[m][bj] = E.load(rowb + ai * HALF + m * 16, colb + bj * HALF);
#pragma unroll
        for (int m = 0; m < 4; ++m)
#pragma unroll
          for (int bj = 0; bj < 2; ++bj) {
            E(rowb + ai * HALF + m * 16, colb + bj * HALF, acc[ai][bj][m][0], acc[ai][bj][m][1], pre[m][bj], up, bj);
            if (Epi::SERIAL) __builtin_amdgcn_sched_barrier(0);
          }
      }
    }
    if (!has_next) break;
#pragma unroll
    for (int a = 0; a < 2; ++a)
#pragma unroll
      for (int b = 0; b < 2; ++b)
#pragma unroll
        for (int m = 0; m < 4; ++m)
#pragma unroll
          for (int n = 0; n < 2; ++n) acc[a][b][m][n] = (f32x4){0.f, 0.f, 0.f, 0.f};
    cur = nxt; cA = nA; cB = nB; ++ui;
  }
  PG8_WAIT_V(0);
  if (wr == 0) PG8_BAR;
  PG8_BAR;
#undef PG8_SA
#undef PG8_SB
#undef PG8_STAGE
#undef PG8_LDA
#undef PG8_LDB
#undef PG8_MMA
#undef PG8_WAIT_V
#undef PG8_WAIT_L
#undef PG8_BAR
#undef PG8_SCHED
}
}

#define BP(T, base, byteoff) ((T*)((char*)(base) + (unsigned)(byteoff)))
#define CBP(T, base, byteoff) ((const T*)((const char*)(base) + (unsigned)(byteoff)))
struct NoPre {};
struct EpiZ {
  static constexpr bool SERIAL = false;
  typedef NoPre Pre; typedef NoPre UPre;
  u16* Z;
  __device__ __forceinline__ UPre uload(int, int) const { return UPre{}; }
  __device__ __forceinline__ Pre load(int, int) const { return Pre{}; }
  __device__ __forceinline__ void operator()(int row, int cb, f32x4 v0, f32x4 v1, const Pre&, const UPre&, int) const {
    const unsigned o = ((unsigned)row * LDZ + cb) * 2u;
    if (cb < LDZ) { u32x2 t; t.x = pack2(v0[0], v0[1]); t.y = pack2(v0[2], v0[3]); *BP(u32x2, Z, o) = t; }
    if (cb + 16 < LDZ) { u32x2 t; t.x = pack2(v1[0], v1[1]); t.y = pack2(v1[2], v1[3]); *BP(u32x2, Z, o + 32u) = t; }
  }
};
struct EpiQ {
  static constexpr bool SERIAL = false;
  struct Pre { f32x4 cs, sn; };
  typedef NoPre UPre;
  u16* Q; const float* tab;
  __device__ __forceinline__ UPre uload(int, int) const { return UPre{}; }
  __device__ __forceinline__ Pre load(int row, int cb) const {
    Pre r; r.cs = (f32x4){1.f, 1.f, 1.f, 1.f}; r.sn = (f32x4){0.f, 0.f, 0.f, 0.f};
    if ((cb & ~15) % 96 == 64) {
      const unsigned to = ((unsigned)pos_of(row) * 32 + (cb & 15)) * 4u;
      r.cs = *CBP(f32x4, tab, to); r.sn = *CBP(f32x4, tab, to + 64u);
    }
    return r;
  }
  __device__ __forceinline__ void operator()(int row, int cb, f32x4 v0, f32x4 v1, const Pre& pr, const UPre&, int) const {
    const float sc = 0.1472444460259031f;
    if ((cb & ~15) % 96 == 64) {
#pragma unroll
      for (int j = 0; j < 4; ++j) {
        float x1 = v0[j], x2 = v1[j];
        v0[j] = x1 * pr.cs[j] - x2 * pr.sn[j];
        v1[j] = x1 * pr.sn[j] + x2 * pr.cs[j];
      }
    }
    u32x2 o0, o1;
    o0.x = pack2(v0[0] * sc, v0[1] * sc); o0.y = pack2(v0[2] * sc, v0[3] * sc);
    o1.x = pack2(v1[0] * sc, v1[1] * sc); o1.y = pack2(v1[2] * sc, v1[3] * sc);
    const unsigned o = ((unsigned)row * 768 + cb) * 2u;
    *BP(u32x2, Q, o) = o0;
    *BP(u32x2, Q, o + 32u) = o1;
  }
};
__device__ __forceinline__ void kv_store(u16* kn, u16* vt, unsigned knrow, unsigned vtbase, unsigned vstride, int cb, f32x4 v0, f32x4 v1) {
  const int hd = cb >> 7, wi = cb & 127;
  if (wi < 64) {
    u32x2 o0, o1;
    o0.x = pack2(v0[0], v0[1]); o0.y = pack2(v0[2], v0[3]); o1.x = pack2(v1[0], v1[1]); o1.y = pack2(v1[2], v1[3]);
    const unsigned o = (knrow * 512 + hd * 64 + wi) * 2u;
    *BP(u32x2, kn, o) = o0;
    *BP(u32x2, kn, o + 32u) = o1;
  } else {
    const unsigned o = (vtbase + (unsigned)(hd * 64 + wi - 64) * vstride) * 2u;
#pragma unroll
    for (int j = 0; j < 4; ++j) {
      *BP(u16, vt, o + (unsigned)j * vstride * 2u) = f2bf(v0[j]);
      *BP(u16, vt, o + (unsigned)(16 + j) * vstride * 2u) = f2bf(v1[j]);
    }
  }
}
template <int MODE>
struct EpiKV {
  static constexpr bool SERIAL = false;
  typedef NoPre Pre; typedef NoPre UPre;
  u16 *KNp, *VTp, *KNs, *VTs;
  __device__ __forceinline__ UPre uload(int, int) const { return UPre{}; }
  __device__ __forceinline__ Pre load(int, int) const { return Pre{}; }
  __device__ __forceinline__ void operator()(int row, int cb, f32x4 v0, f32x4 v1, const Pre&, const UPre&, int) const {
    if (MODE == 0 && row < NP) {
      kv_store(KNp, VTp, (unsigned)row, (unsigned)(row >> 14) * 512u * TSEQ + (unsigned)(row & (TSEQ - 1)), TSEQ, cb, v0, v1);
    } else {
      unsigned bs, sx;
      if (MODE == 0) { bs = (unsigned)(row - NP) >> 4; sx = 2048u + ((unsigned)(row - NP) & 15u); } else { bs = (unsigned)row >> 11; sx = (unsigned)row & 2047u; }
      kv_store(KNs, VTs, bs * SKV + sx, bs * 512u * SKV + sx, SKV, cb, v0, v1);
    }
  }
};
struct EpiMixA {
  static constexpr bool SERIAL = false;
  struct Pre { u32x2 g[2]; };
  typedef NoPre UPre;
  const u16* Z; u16* MX;
  __device__ __forceinline__ UPre uload(int, int) const { return UPre{}; }
  __device__ __forceinline__ Pre load(int row, int cb) const {
    Pre r; const unsigned o = ((unsigned)row * LDZ + ZGA + cb) * 2u;
    r.g[0] = *CBP(u32x2, Z, o); r.g[1] = *CBP(u32x2, Z, o + 32u); return r;
  }
  __device__ __forceinline__ void operator()(int row, int cb, f32x4 v0, f32x4 v1, const Pre& pr, const UPre&, int) const {
    f32x4 v[2] = {v0, v1};
#pragma unroll
    for (int n = 0; n < 2; ++n) {
      const u32x2 g = pr.g[n];
      u32x2 o;
      o.x = pack2(sigmoidf_(bflo(g.x)) * v[n][0], sigmoidf_(bfhi(g.x)) * v[n][1]);
      o.y = pack2(sigmoidf_(bflo(g.y)) * v[n][2], sigmoidf_(bfhi(g.y)) * v[n][3]);
      *BP(u32x2, MX, ((unsigned)row * 1024 + cb + n * 16) * 2u) = o;
    }
  }
};
struct EpiMixB {
  static constexpr bool SERIAL = false;
  struct Pre { u32x2 g[2]; u32x2 a[2]; };
  typedef NoPre UPre;
  const u16* Z; u16* MX;
  __device__ __forceinline__ UPre uload(int, int) const { return UPre{}; }
  __device__ __forceinline__ Pre load(int row, int cb) const {
    Pre r; const unsigned o = ((unsigned)row * LDZ + ZGB + cb) * 2u, m = ((unsigned)row * 1024 + cb) * 2u;
    r.g[0] = *CBP(u32x2, Z, o); r.g[1] = *CBP(u32x2, Z, o + 32u);
    r.a[0] = *CBP(u32x2, MX, m); r.a[1] = *CBP(u32x2, MX, m + 32u); return r;
  }
  __device__ __forceinline__ void operator()(int row, int cb, f32x4 v0, f32x4 v1, const Pre& pr, const UPre&, int) const {
    f32x4 v[2] = {v0, v1};
#pragma unroll
    for (int n = 0; n < 2; ++n) {
      const u32x2 g = pr.g[n], a = pr.a[n];
      u32x2 o;
      o.x = pack2(bflo(a.x) + sigmoidf_(bflo(g.x)) * v[n][0], bfhi(a.x) + sigmoidf_(bfhi(g.x)) * v[n][1]);
      o.y = pack2(bflo(a.y) + sigmoidf_(bflo(g.y)) * v[n][2], bfhi(a.y) + sigmoidf_(bfhi(g.y)) * v[n][3]);
      *BP(u32x2, MX, ((unsigned)row * 1024 + cb + n * 16) * 2u) = o;
    }
  }
};
struct EpiRes1 {
  static constexpr bool SERIAL = false;
  struct Pre { f32x4 x[2]; };
  struct UPre { f32x4 g[2][2]; };
  const float *xp, *xs, *mod; float* XR;
  __device__ __forceinline__ UPre uload(int row, int colb) const {
    UPre u; const unsigned go = ((unsigned)bidx_of(row) * 6144 + 2048 + colb) * 4u;
#pragma unroll
    for (int bj = 0; bj < 2; ++bj)
#pragma unroll
      for (int n = 0; n < 2; ++n) u.g[bj][n] = *CBP(f32x4, mod, go + bj * 512u + n * 64u);
    return u;
  }
  __device__ __forceinline__ Pre load(int row, int cb) const {
    Pre r;
    const float* base = row < NP ? xp : xs;
    const unsigned o = ((unsigned)(row < NP ? row : row - NP) * 1024 + cb) * 4u;
    r.x[0] = *CBP(f32x4, base, o); r.x[1] = *CBP(f32x4, base, o + 64u);
    return r;
  }
  __device__ __forceinline__ void operator()(int row, int cb, f32x4 v0, f32x4 v1, const Pre& pr, const UPre& up, int bj) const {
    f32x4 v[2] = {v0, v1};
#pragma unroll
    for (int n = 0; n < 2; ++n) {
      const f32x4 x = pr.x[n], gg = up.g[bj][n]; f32x4 o;
      o.x = x.x + gg.x * v[n][0]; o.y = x.y + gg.y * v[n][1]; o.z = x.z + gg.z * v[n][2]; o.w = x.w + gg.w * v[n][3];
      *BP(f32x4, XR, ((unsigned)row * 1024 + cb + n * 16) * 4u) = o;
    }
  }
};
struct EpiRes2 {
  static constexpr bool SERIAL = false;
  struct Pre { f32x4 x[2]; };
  struct UPre { f32x4 g[2][2]; };
  const float* mod; float* XR;
  __device__ __forceinline__ UPre uload(int row, int colb) const {
    UPre u; const unsigned go = ((unsigned)bidx_of(row) * 6144 + 5120 + colb) * 4u;
#pragma unroll
    for (int bj = 0; bj < 2; ++bj)
#pragma unroll
      for (int n = 0; n < 2; ++n) u.g[bj][n] = *CBP(f32x4, mod, go + bj * 512u + n * 64u);
    return u;
  }
  __device__ __forceinline__ Pre load(int row, int cb) const {
    Pre r; const unsigned o = ((unsigned)row * 1024 + cb) * 4u;
    r.x[0] = *CBP(f32x4, XR, o); r.x[1] = *CBP(f32x4, XR, o + 64u); return r;
  }
  __device__ __forceinline__ void operator()(int row, int cb, f32x4 v0, f32x4 v1, const Pre& pr, const UPre& up, int bj) const {
    f32x4 v[2] = {v0, v1};
#pragma unroll
    for (int n = 0; n < 2; ++n) {
      const f32x4 x = pr.x[n], gg = up.g[bj][n]; f32x4 o;
      o.x = x.x + gg.x * v[n][0]; o.y = x.y + gg.y * v[n][1]; o.z = x.z + gg.z * v[n][2]; o.w = x.w + gg.w * v[n][3];
      *BP(f32x4, XR, ((unsigned)row * 1024 + cb + n * 16) * 4u) = o;
    }
  }
};
struct EpiSwiglu {
  static constexpr bool SERIAL = false;
  typedef NoPre Pre; typedef NoPre UPre;
  u16* ACT;
  __device__ __forceinline__ UPre uload(int, int) const { return UPre{}; }
  __device__ __forceinline__ Pre load(int, int) const { return Pre{}; }
  __device__ __forceinline__ void operator()(int row, int cb, f32x4 v0, f32x4 v1, const Pre&, const UPre&, int) const {
    const int acol = ((cb & ~15) >> 5) * 16 + (cb & 15);
    float r[4];
#pragma unroll
    for (int j = 0; j < 4; ++j) { r[j] = siluf_(v0[j]) * v1[j]; }
    u32x2 o; o.x = pack2(r[0], r[1]); o.y = pack2(r[2], r[3]);
    *BP(u32x2, ACT, ((unsigned)row * 2816 + acol) * 2u) = o;
  }
};

template <class Epi>
__device__ __forceinline__ void sgemm_rows(const u16* __restrict__ A, int lda, const u16* __restrict__ Bt, int K, int N, const Epi& E, float* sred) {
  const int tid = otid(), lane = tid & 63, w = tid >> 6, lr = lane & 15, lg = lane >> 4;
  const int quad = w >> 2, kq = w & 3;
  const int ntr = NS >> 4, T = (N >> 5) * ntr, KL = K >> 2;
  for (int base = obid() * 2; base < T; base += gridDim.x * 2) {
    const int t = base + quad;
    const bool valid = t < T;
    const int tr = t % ntr, tc = t / ntr;
    const int erow = NP + tr * 16 + lr, ecb = tc * 32 + lg * 4;
    f32x4 c0 = {0.f, 0.f, 0.f, 0.f}, c1 = {0.f, 0.f, 0.f, 0.f};
    typename Epi::UPre up; typename Epi::Pre pre;
    if (valid && kq == 0) { up = E.uload(erow, ecb); pre = E.load(erow, ecb); }
    if (valid) {
      const u16* a = A + (size_t)(NP + tr * 16 + lr) * lda + kq * KL + lg * 8;
      const u16* b0 = Bt + (size_t)(tc * 32 + lr) * K + kq * KL + lg * 8;
      const u16* b1 = b0 + (size_t)16 * K;
#pragma unroll 4
      for (int k = 0; k < KL; k += 64) {
        bf16x8 fa[2], fb0[2], fb1[2];
#pragma unroll
        for (int i = 0; i < 2; ++i) { fa[i] = *(const bf16x8*)(a + k + i * 32); fb0[i] = *(const bf16x8*)(b0 + k + i * 32); fb1[i] = *(const bf16x8*)(b1 + k + i * 32); }
#pragma unroll
        for (int i = 0; i < 2; ++i) { c0 = MFMA(fb0[i], fa[i], c0); c1 = MFMA(fb1[i], fa[i], c1); }
      }
    }
    __syncthreads();
    if (kq != 0) {
      float* r = sred + ((quad * 3 + (kq - 1)) * 8) * 64 + lane;
#pragma unroll
      for (int j = 0; j < 4; ++j) { r[j * 64] = c0[j]; r[(4 + j) * 64] = c1[j]; }
    }
    __syncthreads();
    if (kq == 0 && valid) {
#pragma unroll
      for (int q = 0; q < 3; ++q) {
        const float* r = sred + ((quad * 3 + q) * 8) * 64 + lane;
#pragma unroll
        for (int j = 0; j < 4; ++j) { c0[j] += r[j * 64]; c1[j] += r[(4 + j) * 64]; }
      }
      E(erow, ecb, c0, c1, pre, up, 0);
    }
  }
}

template <bool outmode>
__device__ __forceinline__ void hgrn_run(const Params& p, int pairitem, unsigned char* smraw0) {
  const int tidf = otid();
  const int half = tidf >> 8;
  unsigned char* smraw = smraw0 + half * HG_LDS;
  const int item = pairitem * 2 + half;
  u16* sQ = (u16*)smraw;
  u16* sK = sQ + 32 * 136;
  u16* sKT = sK + 32 * 136;
  u16* sVT = sKT + 128 * 40;
  u16* sAtt = sVT + 128 * 40;
  float* sDec = (float*)(sAtt + 32 * 40);
  float* sSq = sDec + 128;
  const int tid = tidf & 255, lane = tid & 63, w = tid >> 6, lr = lane & 15, lg = lane >> 4;
  int h, tok0, nblk, nv; size_t hsbase = 0; const float* s0 = nullptr; float* sout = nullptr; int decidx = 0;
  if (item < 512) {
    const int bh = item >> 6, r = item & 63;
    h = bh & 3; tok0 = (bh >> 2) * TSEQ + r * 256; nblk = 8; nv = 32;
    hsbase = (size_t)item << 14; decidx = item * 128;
    if (outmode) s0 = p.HS + hsbase;
  } else {
    const int si = item - 512, bs = si >> 2;
    h = si & 3; tok0 = NP + bs * 16; nblk = 1; nv = 16;
    s0 = p.state_hgrn + ((size_t)si << 14);
    sout = p.out + O_HSS + ((size_t)si << 14);
  }
  f32x4 accS[8][2];
#pragma unroll
  for (int mt = 0; mt < 8; ++mt)
#pragma unroll
    for (int nt = 0; nt < 2; ++nt) {
      if (s0) {
#pragma unroll
        for (int j = 0; j < 4; ++j) accS[mt][nt][j] = s0[(mt * 16 + lg * 4 + j) * 128 + w * 32 + nt * 16 + lr];
      } else accS[mt][nt] = (f32x4){0.f, 0.f, 0.f, 0.f};
    }
  float* sP = sSq + 128;
  const int cp = tid & 63, tg = tid >> 6;
  const float lb0 = sigmoidf_(p.lb_param[h * 128 + 2 * cp] - p.lb_param[512 + h * 128 + 2 * cp]);
  const float lb1 = sigmoidf_(p.lb_param[h * 128 + 2 * cp + 1] - p.lb_param[512 + h * 128 + 2 * cp + 1]);
  const float om0 = 1.0f - lb0, om1 = 1.0f - lb1;
  float dtot0 = 1.f, dtot1 = 1.f;
  const float hgscale = 0.08838834764831845f;
  unsigned rf[8], rq[8], rv[8];
#define HG_LOAD(BLK)                                                                                           \
  {                                                                                                            \
    const u16* zb_ = p.Z + (size_t)(tok0 + (BLK) * 32 + tg * 8) * LDZ + h * 128 + 2 * cp;                      \
    _Pragma("unroll") for (int i = 0; i < 8; ++i) {                                                            \
      if (tg * 8 + i < nv) {                                                                                   \
        const u16* z = zb_ + (size_t)i * LDZ;                                                                  \
        rf[i] = *(const unsigned*)(z + ZHF); rv[i] = *(const unsigned*)(z + ZHI);                              \
        rq[i] = outmode ? *(const unsigned*)(z + ZHQ) : 0u;                                                    \
      } else { rf[i] = 0u; rv[i] = 0u; rq[i] = 0u; }                                                           \
    }                                                                                                          \
  }
  HG_LOAD(0)

#pragma unroll 1
  for (int blk = 0; blk < nblk; ++blk) {
    const int tb = tok0 + blk * 32;
    {
      float eb0 = 1.f, eb1 = 1.f;
      float q0[8], q1[8], k0[8], k1[8];
#pragma unroll
      for (int i = 0; i < 8; ++i) {
        q0[i] = 0.f; q1[i] = 0.f; k0[i] = 0.f; k1[i] = 0.f;
        if (tg * 8 + i < nv) {
          const float e0 = __expf(-bflo(rf[i])), e1 = __expf(-bfhi(rf[i]));
          const float s0_ = frcp(1.0f + e0), s1_ = frcp(1.0f + e1);
          eb0 *= lb0 + om0 * s0_; eb1 *= lb1 + om1 * s1_;
          k0[i] = om0 * e0 * s0_ * frcp(eb0); k1[i] = om1 * e1 * s1_ * frcp(eb1);
          if (outmode) { q0[i] = siluf_(bflo(rq[i])) * hgscale * eb0; q1[i] = siluf_(bfhi(rq[i])) * hgscale * eb1; }
        }
      }
      sP[tg * 128 + 2 * cp] = eb0; sP[tg * 128 + 2 * cp + 1] = eb1;
      __syncthreads();
      float pre0 = 1.f, pre1 = 1.f;
#pragma unroll
      for (int g = 0; g < 3; ++g) if (g < tg) { pre0 *= sP[g * 128 + 2 * cp]; pre1 *= sP[g * 128 + 2 * cp + 1]; }
      if (tg == 3) { const float d0 = pre0 * eb0, d1 = pre1 * eb1; sDec[2 * cp] = d0; sDec[2 * cp + 1] = d1; dtot0 *= d0; dtot1 *= d1; }
      const float in0 = frcp(pre0), in1 = frcp(pre1);
#pragma unroll
      for (int i = 0; i < 8; ++i) {
        k0[i] *= in0; k1[i] *= in1;
        if (outmode) {
          const int t = tg * 8 + i;
          *(unsigned*)&sQ[t * 136 + 2 * cp] = pack2(q0[i] * pre0, q1[i] * pre1);
          *(unsigned*)&sK[t * 136 + 2 * cp] = pack2(k0[i], k1[i]);
        }
      }
      { u32x4 a = {pack2(k0[0], k0[1]), pack2(k0[2], k0[3]), pack2(k0[4], k0[5]), pack2(k0[6], k0[7])};
        u32x4 c = {pack2(k1[0], k1[1]), pack2(k1[2], k1[3]), pack2(k1[4], k1[5]), pack2(k1[6], k1[7])};
        *(u32x4*)&sKT[(2 * cp) * 40 + tg * 8] = a; *(u32x4*)&sKT[(2 * cp + 1) * 40 + tg * 8] = c; }
      { u32x4 a, c;
        a.x = (rv[0] & 0xffffu) | (rv[1] << 16); a.y = (rv[2] & 0xffffu) | (rv[3] << 16);
        a.z = (rv[4] & 0xffffu) | (rv[5] << 16); a.w = (rv[6] & 0xffffu) | (rv[7] << 16);
        c.x = (rv[0] >> 16) | (rv[1] & 0xffff0000u); c.y = (rv[2] >> 16) | (rv[3] & 0xffff0000u);
        c.z = (rv[4] >> 16) | (rv[5] & 0xffff0000u); c.w = (rv[6] >> 16) | (rv[7] & 0xffff0000u);
        *(u32x4*)&sVT[(2 * cp) * 40 + tg * 8] = a; *(u32x4*)&sVT[(2 * cp + 1) * 40 + tg * 8] = c; }
    }
    __syncthreads();
    if (blk + 1 < nblk) HG_LOAD(blk + 1)
    f32x4 ot[2][2];
    if (outmode) {
      {
        const int si = w & 1, ti = w >> 1;
        f32x4 at = (f32x4){0.f, 0.f, 0.f, 0.f};
#pragma unroll
        for (int ks = 0; ks < 4; ++ks) {
          bf16x8 a = *(const bf16x8*)&sK[(si * 16 + lr) * 136 + ks * 32 + lg * 8];
          bf16x8 b = *(const bf16x8*)&sQ[(ti * 16 + lr) * 136 + ks * 32 + lg * 8];
          at = MFMA(a, b, at);
        }
        const int t = ti * 16 + lr, sb = si * 16 + lg * 4;
        float m0 = (sb + 0 <= t) ? at[0] : 0.f, m1 = (sb + 1 <= t) ? at[1] : 0.f, m2 = (sb + 2 <= t) ? at[2] : 0.f, m3 = (sb + 3 <= t) ? at[3] : 0.f;
        u32x2 o; o.x = pack2(m0, m1); o.y = pack2(m2, m3);
        *(u32x2*)&sAtt[t * 40 + sb] = o;
      }
      __syncthreads();
#pragma unroll
      for (int vt = 0; vt < 2; ++vt)
#pragma unroll
        for (int tt = 0; tt < 2; ++tt) ot[vt][tt] = (f32x4){0.f, 0.f, 0.f, 0.f};
      {
        bf16x8 bq[2];
#pragma unroll
        for (int tt = 0; tt < 2; ++tt) bq[tt] = *(const bf16x8*)&sAtt[(tt * 16 + lr) * 40 + lg * 8];
#pragma unroll
        for (int vt = 0; vt < 2; ++vt) {
          bf16x8 a = *(const bf16x8*)&sVT[(w * 32 + vt * 16 + lr) * 40 + lg * 8];
#pragma unroll
          for (int tt = 0; tt < 2; ++tt) ot[vt][tt] = MFMA(a, bq[tt], ot[vt][tt]);
        }
      }
#pragma unroll
      for (int kk = 0; kk < 4; ++kk) {
        bf16x8 bq[2];
#pragma unroll
        for (int tt = 0; tt < 2; ++tt)
          bq[tt] = cat8(*(const u32x2*)&sQ[(tt * 16 + lr) * 136 + (2 * kk) * 16 + lg * 4],
                        *(const u32x2*)&sQ[(tt * 16 + lr) * 136 + (2 * kk + 1) * 16 + lg * 4]);
#pragma unroll
        for (int vt = 0; vt < 2; ++vt) {
          bf16x8 a = mk8(pack2(accS[2 * kk][vt][0], accS[2 * kk][vt][1]), pack2(accS[2 * kk][vt][2], accS[2 * kk][vt][3]),
                         pack2(accS[2 * kk + 1][vt][0], accS[2 * kk + 1][vt][1]), pack2(accS[2 * kk + 1][vt][2], accS[2 * kk + 1][vt][3]));
#pragma unroll
          for (int tt = 0; tt < 2; ++tt) ot[vt][tt] = MFMA(a, bq[tt], ot[vt][tt]);
        }
      }
    }
    {
      bf16x8 bv[2];
#pragma unroll
      for (int nt = 0; nt < 2; ++nt) bv[nt] = *(const bf16x8*)&sVT[(w * 32 + nt * 16 + lr) * 40 + lg * 8];
#pragma unroll
      for (int mt = 0; mt < 8; ++mt) {
        bf16x8 a = *(const bf16x8*)&sKT[(mt * 16 + lr) * 40 + lg * 8];
        f32x4 dc = *(const f32x4*)&sDec[mt * 16 + lg * 4];
#pragma unroll
        for (int nt = 0; nt < 2; ++nt) {
          f32x4 r = MFMA(a, bv[nt], accS[mt][nt]);
          r[0] *= dc.x; r[1] *= dc.y; r[2] *= dc.z; r[3] *= dc.w;
          accS[mt][nt] = r;
        }
      }
    }
    if (outmode) {
#pragma unroll
      for (int tt = 0; tt < 2; ++tt) {
        float ss = 0.f;
#pragma unroll
        for (int vt = 0; vt < 2; ++vt)
#pragma unroll
          for (int j = 0; j < 4; ++j) ss += ot[vt][tt][j] * ot[vt][tt][j];
        ss += __shfl_xor(ss, 16); ss += __shfl_xor(ss, 32);
        if (lg == 0) sSq[w * 32 + tt * 16 + lr] = ss;
      }
      __syncthreads();
#pragma unroll
      for (int tt = 0; tt < 2; ++tt) {
        const int t = tt * 16 + lr;
        const float tot = sSq[t] + sSq[32 + t] + sSq[64 + t] + sSq[96 + t];
        const float rstd = rsqrtf(tot * (1.0f / 128.0f) + 1e-6f);
        if (t < nv) {
          u16* z = p.Z + (size_t)(tb + t) * LDZ + h * 128;
#pragma unroll
          for (int vt = 0; vt < 2; ++vt) {
            const int vch = w * 32 + vt * 16 + lg * 4;
            u32x2 g = *(const u32x2*)(z + ZHG + vch);
            f32x4 nw = *(const f32x4*)(p.hg_norm + vch);
            float g0 = bflo(g.x), g1 = bfhi(g.x), g2 = bflo(g.y), g3 = bfhi(g.y);
            float r0 = ot[vt][tt][0] * rstd * nw.x * siluf_(g0);
            float r1 = ot[vt][tt][1] * rstd * nw.y * siluf_(g1);
            float r2 = ot[vt][tt][2] * rstd * nw.z * siluf_(g2);
            float r3 = ot[vt][tt][3] * rstd * nw.w * siluf_(g3);
            u32x2 o; o.x = pack2(r0, r1); o.y = pack2(r2, r3);
            *(u32x2*)(z + ZHQ + vch) = o;
          }
        }
      }
    }
    __syncthreads();
  }
  if (!outmode) {
#pragma unroll
    for (int mt = 0; mt < 8; ++mt)
#pragma unroll
      for (int nt = 0; nt < 2; ++nt)
#pragma unroll
        for (int j = 0; j < 4; ++j) p.HS[hsbase + (mt * 16 + lg * 4 + j) * 128 + w * 32 + nt * 16 + lr] = accS[mt][nt][j];
    if (tg == 3) { p.DEC[decidx + 2 * cp] = dtot0; p.DEC[decidx + 2 * cp + 1] = dtot1; }
  } else if (sout) {
#pragma unroll
    for (int mt = 0; mt < 8; ++mt)
#pragma unroll
      for (int nt = 0; nt < 2; ++nt)
#pragma unroll
        for (int j = 0; j < 4; ++j) sout[(mt * 16 + lg * 4 + j) * 128 + w * 32 + nt * 16 + lr] = accS[mt][nt][j];
  }
}

__device__ __forceinline__ void hgrn_scan(const Params& p, int it) {
  const int e = it * NTHR + otid();
  const int bh = e >> 14, rem = e & 16383, kch = rem >> 7;
  float S = 0.f;
#pragma unroll 1
  for (int r0 = 0; r0 < 64; r0 += 16) {
    float L[16], d[16];
#pragma unroll
    for (int i = 0; i < 16; ++i) {
      L[i] = p.HS[((size_t)(bh * 64 + r0 + i) << 14) + rem];
      d[i] = p.DEC[(bh * 64 + r0 + i) * 128 + kch];
    }
#pragma unroll
    for (int i = 0; i < 16; ++i) {
      p.HS[((size_t)(bh * 64 + r0 + i) << 14) + rem] = S;
      S = d[i] * S + L[i];
    }
  }
  p.out[O_HSP + e] = S;
}

typedef __attribute__((ext_vector_type(16))) float f32x16;
#define MFMA32(a, b, c) __builtin_amdgcn_mfma_f32_32x32x16_bf16((a), (b), (c), 0, 0, 0)
__device__ __forceinline__ void attn_prompt(const Params& p, int item, unsigned char* smraw) {
  u16* sb0 = (u16*)smraw;
  const int tid = otid(), lane = tid & 63, w = tid >> 6, lq = lane & 31, hh = lane >> 5;
  const int qb = 63 - (item >> 4), bh = item & 15, b = bh >> 3, h = bh & 7;
  const int ntr = 2 * qb + 2;
  const int nvis = 4 * qb + (w >> 1) + 1;
  const int q0 = b * TSEQ + qb * 256 + w * 32;
  bf16x8 qf[6];
#pragma unroll
  for (int ks = 0; ks < 6; ++ks) qf[ks] = *(const bf16x8*)(p.Q + (size_t)(q0 + lq) * 768 + h * 96 + ks * 16 + hh * 8);
  f32x16 ot[2];
#pragma unroll
  for (int dt = 0; dt < 2; ++dt)
#pragma unroll
    for (int r = 0; r < 16; ++r) ot[dt][r] = 0.f;
  float nm = 0.f, lrun = 0.f;
  bool first = true;
  u32x4 rk[2], rr, rv[2];
#define ATT_BUF_U16 22016
#define ATT_LOAD(TR)                                                                                          \
  {                                                                                                           \
    const int kb_ = b * TSEQ + (TR) * 128;                                                                    \
    _Pragma("unroll") for (int i = 0; i < 2; ++i) {                                                           \
      const int c_ = tid + i * 512;                                                                           \
      rk[i] = *(const u32x4*)(p.KNp + (size_t)(kb_ + (c_ >> 3)) * 512 + h * 64 + (c_ & 7) * 8);              \
      rv[i] = *(const u32x4*)(p.VTp + ((size_t)(b * 512 + h * 64 + (c_ >> 4))) * TSEQ + (TR) * 128 + (c_ & 15) * 8); \
    }                                                                                                         \
    rr = *(const u32x4*)(p.Z + (size_t)(kb_ + (tid >> 2)) * LDZ + ZKR + (tid & 3) * 8);                       \
  }
#define ATT_WRITE(BI)                                                                                         \
  {                                                                                                           \
    u16* k_ = sb0 + (BI) * ATT_BUF_U16; u16* v_ = k_ + 128 * 104;                                             \
    _Pragma("unroll") for (int i = 0; i < 2; ++i) {                                                           \
      const int c_ = tid + i * 512;                                                                           \
      *(u32x4*)&k_[(c_ >> 3) * 104 + (c_ & 7) * 8] = rk[i];                                                   \
      u16* vd_ = &v_[(c_ >> 4) * 136 + ((c_ & 15) >> 1) * 16 + (c_ & 1) * 4];     \
      *(u32x2*)vd_ = (u32x2){rv[i].x, rv[i].y}; *(u32x2*)(vd_ + 8) = (u32x2){rv[i].z, rv[i].w};               \
    }                                                                                                         \
    *(u32x4*)&k_[(tid >> 2) * 104 + 64 + (tid & 3) * 8] = rr;                                                 \
  }
  ATT_LOAD(0)
  ATT_WRITE(0)
  ATT_LOAD(1)
  __syncthreads();
#pragma unroll 1
  for (int tr = 0; tr < ntr; ++tr) {
    if (tr + 1 < ntr) ATT_WRITE((tr + 1) & 1)
    if (tr + 2 < ntr) ATT_LOAD(tr + 2)
    const u16* sK = sb0 + (tr & 1) * ATT_BUF_U16;
    const u16* sVT = sK + 128 * 104;
    if (2 * tr >= nvis) { __syncthreads(); continue; }
    const bool halfvis = (2 * tr + 1 >= nvis);
    f32x16 st[4];
    f32x16 nmv;
#pragma unroll
    for (int r = 0; r < 16; ++r) nmv[r] = nm;
#pragma unroll
    for (int kt = 0; kt < 4; ++kt) {
      const bf16x8 kf = *(const bf16x8*)&sK[(kt * 32 + lq) * 104 + hh * 8];
      st[kt] = MFMA32(kf, qf[0], nmv);
    }
#pragma unroll
    for (int ks = 1; ks < 6; ++ks)
#pragma unroll
      for (int kt = 0; kt < 4; ++kt) {
        const bf16x8 kf = *(const bf16x8*)&sK[(kt * 32 + lq) * 104 + ks * 16 + hh * 8];
        st[kt] = MFMA32(kf, qf[ks], st[kt]);
      }
    if (__any(halfvis)) {
#pragma unroll
      for (int kt = 2; kt < 4; ++kt)
#pragma unroll
        for (int r = 0; r < 16; ++r) st[kt][r] = -INFINITY;
    }
    {
      float mx = fmaxf(fmaxf(st[0][0], st[0][1]), st[0][2]);
#pragma unroll
      for (int r = 3; r < 16; r += 2) mx = fmaxf(fmaxf(mx, st[0][r]), st[0][r + 1 < 16 ? r + 1 : r]);
#pragma unroll
      for (int kt = 1; kt < 4; ++kt)
#pragma unroll
        for (int r = 0; r < 16; r += 2) mx = fmaxf(fmaxf(mx, st[kt][r]), st[kt][r + 1]);
      mx = max_x32(mx);
      if (first || __any(mx > 8.0f)) {
        const float delta = first ? mx : fmaxf(mx, 0.f);
#pragma unroll
        for (int kt = 0; kt < 4; ++kt)
#pragma unroll
          for (int r = 0; r < 16; ++r) st[kt][r] -= delta;
        nm -= delta;
        if (!first) {
          const float alpha = EXP2(-delta);
          lrun *= alpha;
#pragma unroll
          for (int dt = 0; dt < 2; ++dt)
#pragma unroll
            for (int r = 0; r < 16; ++r) ot[dt][r] *= alpha;
        }
      }
      float ps0 = 0.f, ps1 = 0.f;
#pragma unroll
      for (int kt = 0; kt < 4; ++kt)
#pragma unroll
        for (int r = 0; r < 16; r += 2) {
          const float e0 = EXP2(st[kt][r]), e1 = EXP2(st[kt][r + 1]);
          st[kt][r] = e0; st[kt][r + 1] = e1;
          ps0 += e0; ps1 += e1;
        }
      lrun += ps0 + ps1;
    }
    first = false;
#pragma unroll
    for (int kt = 0; kt < 4; ++kt)
#pragma unroll
      for (int s2 = 0; s2 < 2; ++s2) {
        const bf16x8 pb = mk8(pack2(st[kt][8 * s2 + 0], st[kt][8 * s2 + 1]), pack2(st[kt][8 * s2 + 2], st[kt][8 * s2 + 3]),
                              pack2(st[kt][8 * s2 + 4], st[kt][8 * s2 + 5]), pack2(st[kt][8 * s2 + 6], st[kt][8 * s2 + 7]));
#pragma unroll
        for (int dt = 0; dt < 2; ++dt) {
          const bf16x8 a = *(const bf16x8*)&sVT[(dt * 32 + lq) * 136 + kt * 32 + 16 * s2 + 8 * hh];
          ot[dt] = MFMA32(a, pb, ot[dt]);
        }
      }
    __syncthreads();
  }
#undef ATT_WRITE
#undef ATT_LOAD
  {
    float l = lrun;
    l += __shfl_xor(l, 32);
    const float inv = 1.0f / l;
    u16* o = p.Z + (size_t)(q0 + lq) * LDZ + h * 64;
#pragma unroll
    for (int dt = 0; dt < 2; ++dt)
#pragma unroll
      for (int rg = 0; rg < 4; ++rg) {
        u32x2 v; v.x = pack2(ot[dt][4 * rg + 0] * inv, ot[dt][4 * rg + 1] * inv); v.y = pack2(ot[dt][4 * rg + 2] * inv, ot[dt][4 * rg + 3] * inv);
        *(u32x2*)(o + dt * 32 + 8 * rg + 4 * hh) = v;
      }
  }
}

__device__ __forceinline__ void attn_sample(const Params& p, int item, unsigned char* smraw) {
  float* sM = (float*)smraw;
  float* sL = sM + 512;
  float* sO = sL + 512;
  const int tid = otid(), lane = tid & 63, w = tid >> 6, lr = lane & 15, lg = lane >> 4;
  const int bs = item >> 3, h = item & 7;
  bf16x8 qf[3];
#pragma unroll
  for (int ks = 0; ks < 3; ++ks) qf[ks] = *(const bf16x8*)(p.Q + (size_t)(NP + bs * 16 + lr) * 768 + h * 96 + ks * 32 + lg * 8);
  f32x4 ot[4];
#pragma unroll
  for (int dt = 0; dt < 4; ++dt) ot[dt] = (f32x4){0.f, 0.f, 0.f, 0.f};
  float mrun = -INFINITY, lrun = 0.f;
  for (int kt = w; kt < 33; kt += 8) {
    const size_t kb = (size_t)bs * SKV + kt * 64;
    f32x4 st[4];
#pragma unroll
    for (int a = 0; a < 4; ++a) st[a] = (f32x4){0.f, 0.f, 0.f, 0.f};
#pragma unroll
    for (int a = 0; a < 4; ++a) {
      const size_t krow = kb + a * 16 + lr;
      bf16x8 k0 = *(const bf16x8*)(p.KNs + krow * 512 + h * 64 + lg * 8);
      bf16x8 k1 = *(const bf16x8*)(p.KNs + krow * 512 + h * 64 + 32 + lg * 8);
      bf16x8 k2 = *(const bf16x8*)(p.KRs + krow * 32 + lg * 8);
      st[a] = MFMA(k0, qf[0], st[a]); st[a] = MFMA(k1, qf[1], st[a]); st[a] = MFMA(k2, qf[2], st[a]);
    }
    if (kt == 32) {
#pragma unroll
      for (int a = 1; a < 4; ++a) st[a] = (f32x4){-INFINITY, -INFINITY, -INFINITY, -INFINITY};
    }
    float mx = st[0][0];
#pragma unroll
    for (int a = 0; a < 4; ++a)
#pragma unroll
      for (int j = 0; j < 4; ++j) mx = fmaxf(mx, st[a][j]);
    mx = fmaxf(mx, __shfl_xor(mx, 16)); mx = fmaxf(mx, __shfl_xor(mx, 32));
    const float mnew = fmaxf(mrun, mx);
    const float alpha = EXP2(mrun - mnew);
    mrun = mnew;
    float ps = 0.f;
#pragma unroll
    for (int a = 0; a < 4; ++a)
#pragma unroll
      for (int j = 0; j < 4; ++j) { float e = EXP2(st[a][j] - mnew); st[a][j] = e; ps += e; }
    lrun = lrun * alpha + ps;
#pragma unroll
    for (int dt = 0; dt < 4; ++dt) { ot[dt][0] *= alpha; ot[dt][1] *= alpha; ot[dt][2] *= alpha; ot[dt][3] *= alpha; }
#pragma unroll
    for (int s = 0; s < 2; ++s) {
      bf16x8 pb = mk8(pack2(st[2 * s][0], st[2 * s][1]), pack2(st[2 * s][2], st[2 * s][3]),
                      pack2(st[2 * s + 1][0], st[2 * s + 1][1]), pack2(st[2 * s + 1][2], st[2 * s + 1][3]));
#pragma unroll
      for (int dt = 0; dt < 4; ++dt) {
        const u16* vr = p.VTs + ((size_t)bs * 512 + h * 64 + dt * 16 + lr) * SKV + kt * 64;
        bf16x8 a = cat8(*(const u32x2*)(vr + (2 * s) * 16 + lg * 4), *(const u32x2*)(vr + (2 * s + 1) * 16 + lg * 4));
        ot[dt] = MFMA(a, pb, ot[dt]);
      }
    }
  }
  lrun += __shfl_xor(lrun, 16); lrun += __shfl_xor(lrun, 32);
  __syncthreads();
  sM[w * 64 + lane] = mrun; sL[w * 64 + lane] = lrun;
#pragma unroll
  for (int dt = 0; dt < 4; ++dt)
#pragma unroll
    for (int j = 0; j < 4; ++j) sO[(w * 16 + dt * 4 + j) * 64 + lane] = ot[dt][j];
  __syncthreads();
  if (w < 4) {
    const int dt = w;
    float mm[8], M = -INFINITY;
#pragma unroll
    for (int i = 0; i < 8; ++i) { mm[i] = sM[i * 64 + lane]; M = fmaxf(M, mm[i]); }
    float L = 0.f;
#pragma unroll
    for (int i = 0; i < 8; ++i) { mm[i] = EXP2(mm[i] - M); L += sL[i * 64 + lane] * mm[i]; }
    const float inv = 1.0f / L;
    float r[4];
#pragma unroll
    for (int j = 0; j < 4; ++j) {
      float a = 0.f;
#pragma unroll
      for (int i = 0; i < 8; ++i) a += sO[(i * 16 + dt * 4 + j) * 64 + lane] * mm[i];
      r[j] = a * inv;
    }
    u32x2 v; v.x = pack2(r[0], r[1]); v.y = pack2(r[2], r[3]);
    *(u32x2*)(p.Z + (size_t)(NP + bs * 16 + lr) * LDZ + h * 64 + dt * 16 + lg * 4) = v;
  }
  __syncthreads();
}

__device__ __forceinline__ void run_phase(const Params& p, int ph, unsigned char* smraw, int* sItem) {
  LAS unsigned char* lds = (LAS unsigned char*)smraw;
  const int tid = otid();
#ifdef ONLY_PHASE
  if (ph != ONLY_PHASE) return;
#endif
  switch (ph) {
    case 0: phase0(p, smraw); break;
    case 1: norm_mod(p, 0); break;
    case 2: {
      { EpiZ e{p.Z}; pg8::Gemm g{p.H1, 1024, p.wt_in, 1024, 130, 19}; pg8::gemm_phase(lds, g, e); }
      { EpiKV<1> e{p.KNp, p.VTp, p.KNs, p.VTs}; pg8::Gemm g{p.CKVb, 256, p.wt_ukv, 256, 256, 4}; pg8::gemm_phase(lds, g, e); }
    } break;
    case 3: {
      rowpost(p);
      for (int it = obid(); it < 256; it += gridDim.x) hgrn_run<false>(p, it, smraw);
    } break;
    case 4: {
#ifndef P4SEL
#define P4SEL 3
#endif
      if (P4SEL & 1) { EpiQ e{p.Q, p.tab}; pg8::Gemm g{p.Z, LDZ, p.wt_uq, 384, 130, 3}; pg8::gemm_phase(lds, g, e); }
      if (P4SEL & 2) { EpiKV<0> e{p.KNp, p.VTp, p.KNs, p.VTs}; pg8::Gemm g{p.Z + ZKV, LDZ, p.wt_ukv, 256, 128, 4}; pg8::gemm_phase(lds, g, e); sgemm_rows(p.Z + ZKV, LDZ, p.wt_ukv, 256, 1024, e, (float*)smraw); }
      for (int it = obid(); it < 256; it += gridDim.x) hgrn_scan(p, it);
    } break;
    case 5: {
      const int total = 1024 + 320 + 256;
      for (;;) {
        __syncthreads();
        if (tid == 0) *sItem = (int)atomicAdd(p.ctr, 1u);
        __syncthreads();
        const int it = *sItem;
        if (it >= total) break;
#ifndef ONLY_ITEM
#define ONLY_ITEM 7
#endif
        if (it < 1024) { if (ONLY_ITEM & 1) attn_prompt(p, it, smraw); }
        else if (it < 1024 + 320) { if (ONLY_ITEM & 2) hgrn_run<true>(p, it - 1024, smraw); }
        else { if (ONLY_ITEM & 4) attn_sample(p, it - 1344, smraw); }
      }
    } break;
    case 6: {
      { EpiMixA e{p.Z, p.H}; pg8::Gemm g{p.Z, LDZ, p.wt_pa, 512, 128, 4}; pg8::gemm_phase(lds, g, e); }
      { EpiMixB e{p.Z, p.H}; pg8::Gemm g{p.Z + ZHQ, LDZ, p.wt_pb, 512, 128, 4}; pg8::gemm_phase(lds, g, e); }
      { EpiMixA e{p.Z, p.H}; sgemm_rows(p.Z, LDZ, p.wt_pa, 512, 1024, e, (float*)smraw); }
      { EpiMixB e{p.Z, p.H}; sgemm_rows(p.Z + ZHQ, LDZ, p.wt_pb, 512, 1024, e, (float*)smraw); }
    } break;
    case 7: { EpiRes1 e{p.x_prompt, p.x_sample, p.mod, p.out}; pg8::Gemm g{p.H, 1024, p.wt_out, 1024, 128, 4}; pg8::gemm_phase(lds, g, e); sgemm_rows(p.H, 1024, p.wt_out, 1024, 1024, e, (float*)smraw); } break;
    case 8: norm_mod(p, 1); break;
    case 9: { EpiSwiglu e{p.Z}; pg8::Gemm g{p.H, 1024, p.wt_gu, 1024, 130, 22}; pg8::gemm_phase(lds, g, e); } break;
    case 10: { EpiRes2 e{p.mod, p.out}; pg8::Gemm g{p.Z, 2816, p.wt_dn, 2816, 128, 4}; pg8::gemm_phase(lds, g, e); sgemm_rows(p.Z, 2816, p.wt_dn, 2816, 1024, e, (float*)smraw); } break;
    case 11: final_norm(p); break;
  }
}

__device__ __forceinline__ void xb_setup(unsigned* bar, volatile unsigned* st) {
  if (threadIdx.x == 0) {
    const unsigned x = xb_xcc_id();
    const unsigned G = gridDim.x;
    unsigned cnt = 0u, mine = 1u, sum = 0u, sp = 0u;
    for (;;) {
      sum = 0u; cnt = 0u; mine = 0u;
#pragma unroll
      for (unsigned j = 0; j < 16; ++j) { const unsigned c = xb_ld(&bar[XB_XCNT(j)]); sum += c; cnt += (c > 0u) ? 1u : 0u; mine = (j == x) ? c : mine; }
      if (sum == G) break;
      __builtin_amdgcn_s_sleep(1);
      if ((++sp & 255u) == 0u) { if (xb_ld(&bar[XB_TMO])) break; if (sp > XB_SPIN_CAP) { atomicAdd(&bar[XB_TMO], 1u); break; } }
    }
    st[0] = mine > 0u ? mine : 1u; st[1] = cnt > 0u ? cnt : 1u; st[2] = x;
  }
  __syncthreads();
}

__global__ void __launch_bounds__(NTHR, 2) mega_kernel(Params p) {
  extern __shared__ __attribute__((aligned(16))) unsigned char smraw[];
  int* sItem = (int*)(smraw + STAGE_BYTES);
  cg::grid_group grid = cg::this_grid();
  volatile unsigned* xst = (volatile unsigned*)(smraw + STAGE_BYTES + 16);
  if (blockIdx.x == 0) for (int i = threadIdx.x; i < 4096; i += NTHR) p.ctr[i] = 0u;
  grid.sync();
  if (threadIdx.x == 0) (void)xb_add(&p.ctr[XB_XCNT(xb_xcc_id())], 1u);
#define DO_PHASE(K) if (p.p0 <= (K) && (K) < p.p1) { run_phase(p, (K), smraw, sItem); if ((K) + 1 < p.p1) { if ((K) == 0) xb_setup(p.ctr, xst); xcd_barrier(p.ctr, xst); } }
  DO_PHASE(0) DO_PHASE(1) DO_PHASE(2) DO_PHASE(3) DO_PHASE(4) DO_PHASE(5)
  DO_PHASE(6) DO_PHASE(7) DO_PHASE(8) DO_PHASE(9) DO_PHASE(10) DO_PHASE(11)
}

extern "C" void kernel_launch(void* const* d_in, const int* in_sizes, int n_in, void* d_out, int out_size,
                              void* d_ws, size_t ws_size, hipStream_t stream) {
  static int grid_blocks = 0;
  if (!grid_blocks) {
    int dev = 0, cus = 0, per_cu = 0;
    (void)hipGetDevice(&dev);
    (void)hipDeviceGetAttribute(&cus, hipDeviceAttributeMultiprocessorCount, dev);
    if (hipFuncSetAttribute((const void*)mega_kernel, hipFuncAttributeMaxDynamicSharedMemorySize, LDS_BYTES) != hipSuccess)
      fprintf(stderr, "kernel_launch: hipFuncSetAttribute failed\n");
    (void)hipOccupancyMaxActiveBlocksPerMultiprocessor(&per_cu, (const void*)mega_kernel, NTHR, LDS_BYTES);
    if (per_cu < 1) fprintf(stderr, "kernel_launch: occupancy query says %d blocks/CU\n", per_cu);
    (void)hipGetLastError();
    grid_blocks = cus > 0 ? cus : 256;
  }
  Params p;
  memset(&p, 0, sizeof(p));
  const float* const* in = (const float* const*)d_in;
  p.x_prompt = in[0]; p.x_sample = in[1]; p.cache_ckv = in[2]; p.cache_krope = in[3]; p.state_hgrn = in[4];
  p.c_prompt = in[5]; p.c_sample = in[6]; p.w_in = in[7]; p.q_norm = in[8]; p.w_uq = in[9]; p.kv_norm = in[10];
  p.w_ukv = in[11]; p.lb_param = in[12]; p.hg_norm = in[13]; p.w_pa = in[14]; p.w_pb = in[15]; p.w_out = in[16];
  p.norm1 = in[17]; p.norm2 = in[18]; p.w_ada = in[19]; p.b_ada = in[20]; p.w_gu = in[21]; p.w_down = in[22];
  p.final_norm = in[23];
  p.out = (float*)d_out;
  unsigned char* ws = (unsigned char*)d_ws;
  size_t off = 0;
  auto take = [&](size_t bytes) { unsigned char* r = ws + off; off += (bytes + 255) & ~(size_t)255; return r; };
  p.wt_in = (u16*)take((size_t)4864 * 1024 * 2);
  p.wt_uq = (u16*)take((size_t)768 * 384 * 2);
  p.wt_ukv = (u16*)take((size_t)1024 * 256 * 2);
  p.wt_pa = (u16*)take((size_t)1024 * 512 * 2);
  p.wt_pb = (u16*)take((size_t)1024 * 512 * 2);
  p.wt_out = (u16*)take((size_t)1024 * 1024 * 2);
  p.wt_gu = (u16*)take((size_t)5632 * 1024 * 2);
  p.wt_dn = (u16*)take((size_t)1024 * 2816 * 2);
  p.mod = (float*)take((size_t)34 * 6144 * 4);
  p.tab = (float*)take((size_t)TSEQ * 32 * 4);
  p.ctr = (unsigned*)take(16384);
  p.DEC = (float*)take((size_t)512 * 128 * 4);
  p.HS = (float*)take((size_t)512 * 16384 * 4);
  p.Z = (u16*)take((size_t)NT * LDZ * 2);
  unsigned char* regS = ws + off;
  p.H = (u16*)regS;
  p.KNs = (u16*)regS;
  p.VTs = p.KNs + (size_t)32 * SKV * 512;
  p.KRs = p.VTs + (size_t)32 * 512 * SKV;
  off += (size_t)32 * SKV * 512 * 2 * 2 + (size_t)32 * SKV * 32 * 2;
  if (off > ws_size) { fprintf(stderr, "kernel_launch: workspace too small: need %zu have %zu\n", off, ws_size); return; }
  p.H1 = (u16*)d_out;
  p.Q = (u16*)d_out;
  p.KNp = p.Q + (size_t)NT * 768;
  p.VTp = p.KNp + (size_t)NP * 512;
  p.CKVb = (u16*)((float*)d_out + O_CKVP);
  p.p0 = 0; p.p1 = NPHASE;
  void* args[] = {&p};
  hipError_t e = hipLaunchCooperativeKernel((void*)mega_kernel, dim3(grid_blocks), dim3(NTHR), args, LDS_BYTES, stream);
  if (e != hipSuccess) fprintf(stderr, "cooperative launch failed: %s (grid %d)\n", hipGetErrorString(e), grid_blocks);
}
```

```cpp
#include <hip/hip_runtime.h>
#include <hip/hip_cooperative_groups.h>
#include <cstdio>
#include <cstring>
namespace cg = cooperative_groups;

typedef unsigned short u16;
typedef __attribute__((ext_vector_type(8))) short bf16x8;
typedef __attribute__((ext_vector_type(4))) float f32x4;
typedef __attribute__((ext_vector_type(2))) float f32x2;
typedef __attribute__((ext_vector_type(4))) unsigned u32x4;
typedef __attribute__((ext_vector_type(2))) unsigned u32x2;
#define LAS __attribute__((address_space(3)))

#define NTHR 512
#define NP 32768
#define NS 512
#define NT 33280
#define LDZ 4768
#define ZKV 384
#define ZKR 640
#define ZHQ 672
#define ZHF 1184
#define ZHI 1696
#define ZHG 2208
#define ZGA 2720
#define ZGB 3744
#define SKV 2112
#define TSEQ 16384
#define NPHASE 12

#define O_Y 0
#define O_CKVP 34078720
#define O_KRP 42467328
#define O_HSP 43515904
#define O_CKVS 43646976
#define O_KRS 43778048
#define O_HSS 43794432

#define STAGE_BYTES 131072
#define LDS_BYTES (STAGE_BYTES + 256)
#define HG_LDS 44032

struct Params {
  const float *x_prompt, *x_sample, *cache_ckv, *cache_krope, *state_hgrn, *c_prompt, *c_sample;
  const float *w_in, *q_norm, *w_uq, *kv_norm, *w_ukv, *lb_param, *hg_norm, *w_pa, *w_pb, *w_out;
  const float *norm1, *norm2, *w_ada, *b_ada, *w_gu, *w_down, *final_norm;
  float* out;
  u16 *wt_in, *wt_uq, *wt_ukv, *wt_pa, *wt_pb, *wt_out, *wt_gu, *wt_dn;
  float* mod; float* tab;
  u16* H; u16 *KNs, *VTs, *KRs; u16* Z; float* HS; float* DEC;
  u16 *Q, *KNp, *VTp; u16* H1; u16* CKVb;
  unsigned* ctr;
  int p0, p1;
};

__device__ __forceinline__ bf16x8 mk8(unsigned a, unsigned b, unsigned c, unsigned d) { u32x4 t = {a, b, c, d}; return __builtin_bit_cast(bf16x8, t); }
__device__ __forceinline__ bf16x8 cat8(u32x2 lo, u32x2 hi) { u32x4 t = {lo.x, lo.y, hi.x, hi.y}; return __builtin_bit_cast(bf16x8, t); }

typedef __attribute__((ext_vector_type(2))) __bf16 bf16x2_t;
__device__ __forceinline__ unsigned pack2(float a, float b) { const f32x2 v = {a, b}; return __builtin_bit_cast(unsigned, __builtin_convertvector(v, bf16x2_t)); }
__device__ __forceinline__ u16 f2bf(float f) { return (u16)(pack2(f, f) & 0xffffu); }
__device__ __forceinline__ float bf2f(u16 h) { return __uint_as_float(((unsigned)h) << 16); }
__device__ __forceinline__ float bflo(unsigned u) { return __uint_as_float(u << 16); }
__device__ __forceinline__ float bfhi(unsigned u) { return __uint_as_float(u & 0xffff0000u); }
__device__ __forceinline__ float frcp(float x) { return __builtin_amdgcn_rcpf(x); }
__device__ __forceinline__ float sigmoidf_(float x) { return frcp(1.0f + __expf(-x)); }
__device__ __forceinline__ float siluf_(float x) { return x * frcp(1.0f + __expf(-x)); }
__device__ __forceinline__ float wave_sum(float v) {
#pragma unroll
  for (int o = 32; o > 0; o >>= 1) v += __shfl_xor(v, o);
  return v;
}
__device__ __forceinline__ int otid() { int t = threadIdx.x; asm volatile("" : "+v"(t)); return t; }
__device__ __forceinline__ int obid() { int b = blockIdx.x; asm volatile("" : "+s"(b)); return b; }
#define EXP2(x) __builtin_amdgcn_exp2f(x)
__device__ __forceinline__ float max_x32(float x) { const unsigned u = __float_as_uint(x); auto r = __builtin_amdgcn_permlane32_swap(u, u, false, false); return fmaxf(__uint_as_float(r[0]), __uint_as_float(r[1])); }
__device__ __forceinline__ float max_x16(float x) { const unsigned u = __float_as_uint(x); auto r = __builtin_amdgcn_permlane16_swap(u, u, false, false); return fmaxf(__uint_as_float(r[0]), __uint_as_float(r[1])); }
#define MFMA(a, b, c) __builtin_amdgcn_mfma_f32_16x16x32_bf16((a), (b), (c), 0, 0, 0)

#define XB_TMO      128
#define XB_XCNT(j)  (256  + 64 * (j))
#define XB_XSUB(j)  (1280 + 64 * (j))
#define XB_XGEN(j)  (2304 + 64 * (j))
#define XB_TOP      3328
#define XB_TOPGEN   3392
#define XB_SPIN_CAP (1u << 22)
__device__ __forceinline__ unsigned xb_ld(unsigned* p)              { return __hip_atomic_load(p, __ATOMIC_RELAXED, __HIP_MEMORY_SCOPE_AGENT); }
__device__ __forceinline__ unsigned xb_add(unsigned* p, unsigned v) { return __hip_atomic_fetch_add(p, v, __ATOMIC_RELAXED, __HIP_MEMORY_SCOPE_AGENT); }
__device__ __forceinline__ unsigned xb_xcc_id() { return (unsigned)__builtin_amdgcn_s_getreg((3 << 11) | 20) & 0xFu; }
#define XB_SPIN(cond, bar) do { unsigned _sp = 0; while (cond) { __builtin_amdgcn_s_sleep(1); \
    if ((++_sp & 255u) == 0u) { if (xb_ld(&(bar)[XB_TMO])) break; if (_sp > XB_SPIN_CAP) { atomicAdd(&(bar)[XB_TMO], 1u); break; } } } } while (0)
__device__ __forceinline__ void xcd_barrier(unsigned* bar, volatile unsigned* st  ) {
  asm volatile("s_waitcnt vmcnt(0)" ::: "memory");
  __syncthreads();
  if (threadIdx.x == 0) {
    __builtin_amdgcn_s_waitcnt(0);
    const unsigned nloc = st[0], nx = st[1], x = st[2];
    const unsigned old = xb_add(&bar[XB_XSUB(x)], 1u);
    const unsigned gen = old / nloc;
    if (old + 1u == (gen + 1u) * nloc) {
      __builtin_amdgcn_fence(__ATOMIC_RELEASE, "agent");
      asm volatile("s_waitcnt vmcnt(0)" ::: "memory");
      const unsigned og = xb_add(&bar[XB_TOP], 1u);
      const unsigned tg = og / nx;
      if (og + 1u == (tg + 1u) * nx) xb_add(&bar[XB_TOPGEN], 1u);
      else XB_SPIN(xb_ld(&bar[XB_TOPGEN]) == tg, bar);
      __builtin_amdgcn_fence(__ATOMIC_ACQUIRE, "agent");
      xb_add(&bar[XB_XGEN(x)], 1u);
      asm volatile("s_waitcnt vmcnt(0)" ::: "memory");
    } else {
      XB_SPIN(xb_ld(&bar[XB_XGEN(x)]) == gen, bar);
      __builtin_amdgcn_fence(__ATOMIC_ACQUIRE, "agent");
      asm volatile("s_waitcnt vmcnt(0)" ::: "memory");
    }
  }
  __syncthreads();
}

__device__ __forceinline__ int bidx_of(int row) { return row < NP ? (row >> 14) : 2 + ((row - NP) >> 4); }
__device__ __forceinline__ int pos_of(int row) { return row < NP ? (row & (TSEQ - 1)) : 2048 + ((row - NP) & 15); }

__device__ __forceinline__ void transpose_w(const float* __restrict__ src, u16* __restrict__ dst, int K, int N, int mode, float* tile) {
  const int tid = otid();
  const int nkt = K >> 7, nnt = N >> 5, T = nkt * nnt;
  for (int t = obid(); t < T; t += gridDim.x) {
    const int kt = t % nkt, ntile = t / nkt;
    __syncthreads();
#pragma unroll
    for (int ps = 0; ps < 2; ++ps) {
      const int k = (tid >> 3) + 64 * ps, n4 = (tid & 7) * 4;
      const f32x4 v = __builtin_nontemporal_load((const f32x4*)(src + (size_t)(kt * 128 + k) * N + ntile * 32 + n4));
      tile[k * 33 + n4 + 0] = v.x; tile[k * 33 + n4 + 1] = v.y; tile[k * 33 + n4 + 2] = v.z; tile[k * 33 + n4 + 3] = v.w;
    }
    __syncthreads();
    {
      const int nl = tid >> 4, kc = tid & 15, n = ntile * 32 + nl;
      float f[8];
#pragma unroll
      for (int i = 0; i < 8; ++i) f[i] = tile[(kc * 8 + i) * 33 + nl];
      int R = n;
      if (mode == 1) R = n < 2816 ? ((n >> 4) * 32 + (n & 15)) : (((n - 2816) >> 4) * 32 + 16 + ((n - 2816) & 15));
      u32x4 o = {pack2(f[0], f[1]), pack2(f[2], f[3]), pack2(f[4], f[5]), pack2(f[6], f[7])};
      *(u32x4*)(dst + (size_t)R * K + kt * 128 + kc * 8) = o;
    }
  }
}

__device__ __forceinline__ void adaln(const Params& p, float* sm) {
  const int tid = otid(), lane = tid & 63, w = tid >> 6;
  for (int it = obid(); it < 96; it += gridDim.x) {
    const int col = it * 64 + lane;
    float acc[34];
#pragma unroll
    for (int b = 0; b < 34; ++b) acc[b] = 0.f;
    float* sC = sm + w * (64 * 36);
    for (int kc = 0; kc < 2; ++kc) {
      const int kb = w * 128 + kc * 64;
      __syncthreads();
#pragma unroll
      for (int b = 0; b < 34; ++b) {
        const float* cr = b < 2 ? p.c_prompt + b * 1024 : p.c_sample + (b - 2) * 1024;
        float c = cr[kb + lane];
        sC[lane * 36 + b] = siluf_(c);
      }
      __syncthreads();
#pragma unroll 8
      for (int kk = 0; kk < 64; ++kk) {
        float wv = __builtin_nontemporal_load(p.w_ada + (size_t)(kb + kk) * 6144 + col);
#pragma unroll
        for (int b4 = 0; b4 < 8; ++b4) {
          f32x4 s = *(const f32x4*)&sC[kk * 36 + b4 * 4];
          acc[b4 * 4 + 0] += s.x * wv; acc[b4 * 4 + 1] += s.y * wv; acc[b4 * 4 + 2] += s.z * wv; acc[b4 * 4 + 3] += s.w * wv;
        }
        f32x2 s2 = *(const f32x2*)&sC[kk * 36 + 32];
        acc[32] += s2.x * wv; acc[33] += s2.y * wv;
      }
    }
    __syncthreads();
    float* red = sm;
#pragma unroll
    for (int b = 0; b < 34; ++b) red[(w * 34 + b) * 64 + lane] = acc[b];
    __syncthreads();
    for (int idx = tid; idx < 34 * 64; idx += NTHR) {
      int b = idx >> 6, c = idx & 63;
      float s = 0.f;
#pragma unroll
      for (int ww = 0; ww < 8; ++ww) s += red[(ww * 34 + b) * 64 + c];
      p.mod[b * 6144 + it * 64 + c] = s + p.b_ada[it * 64 + c];
    }
    __syncthreads();
  }
}

__device__ __forceinline__ void phase0(const Params& p, unsigned char* smraw) {
  float* smf = (float*)smraw;
  const int tid = otid();
  adaln(p, smf);
  transpose_w(p.w_in, p.wt_in, 1024, 4768, 0, smf);
  transpose_w(p.w_gu, p.wt_gu, 1024, 5632, 1, smf);
  transpose_w(p.w_down, p.wt_dn, 2816, 1024, 0, smf);
  transpose_w(p.w_out, p.wt_out, 1024, 1024, 0, smf);
  transpose_w(p.w_pa, p.wt_pa, 512, 1024, 0, smf);
  transpose_w(p.w_pb, p.wt_pb, 512, 1024, 0, smf);
  transpose_w(p.w_uq, p.wt_uq, 384, 768, 0, smf);
  transpose_w(p.w_ukv, p.wt_ukv, 256, 1024, 0, smf);
  const size_t gt = (size_t)obid() * NTHR + tid, gn = (size_t)gridDim.x * NTHR;
  for (size_t i = gt; i < (size_t)96 * 1024 / 8; i += gn) *(u32x4*)(p.wt_in + (size_t)4768 * 1024 + i * 8) = (u32x4){0u, 0u, 0u, 0u};
  {
    const int nb = (int)gridDim.x, skip = nb > 96 ? 96 : 0;
    if (obid() >= skip) {
      const size_t ct = (size_t)(obid() - skip) * NTHR + tid, cn = (size_t)(nb - skip) * NTHR;
      for (size_t i = ct; i < (size_t)65536 * 256 / 8; i += cn) {
        const f32x4 a = __builtin_nontemporal_load((const f32x4*)(p.cache_ckv + i * 8)), b = __builtin_nontemporal_load((const f32x4*)(p.cache_ckv + i * 8 + 4));
        u32x4 o = {pack2(a.x, a.y), pack2(a.z, a.w), pack2(b.x, b.y), pack2(b.z, b.w)};
        *(u32x4*)(p.CKVb + i * 8) = o;
      }
    }
  }
  for (size_t i = gt; i < (size_t)TSEQ * 16; i += gn) {
    const int pos = (int)(i >> 4), j = (int)(i & 15);
    const int jm = j & 3, jd = j >> 2;
    double inv = jm == 0 ? 1.0 : (jm == 1 ? 0.5623413251903491 : (jm == 2 ? 0.31622776601683794 : 0.1778279410038923));
    inv *= (jd == 0 ? 1.0 : (jd == 1 ? 0.1 : (jd == 2 ? 0.01 : 0.001)));
    const double a = (double)pos * inv;
    const double k = rint(a * 0.15915494309189535);
    double r = fma(-k, 6.283185307179586, a);
    r = fma(-k, 2.4492935982947064e-16, r);
    const double r2 = r * r;
    double c = 1.0, s = r, tc = 1.0, ts = r;
#pragma unroll 1
    for (int n = 1; n <= 16; ++n) {
      tc *= -r2 / (double)((2 * n - 1) * (2 * n));
      ts *= -r2 / (double)((2 * n) * (2 * n + 1));
      c += tc; s += ts;
    }
    p.tab[pos * 32 + j] = (float)c;
    p.tab[pos * 32 + 16 + j] = (float)s;
  }
  for (size_t i = gt; i < (size_t)32 * SKV * 32; i += gn) {
    int d = (int)(i & 31); size_t r = i >> 5; int s = (int)(r % SKV); int b = (int)(r / SKV);
    if (s < 2048) p.KRs[i] = f2bf(p.cache_krope[((size_t)b * 2048 + s) * 32 + d]);
    else if (s >= 2064) p.KRs[i] = 0;
  }
  for (size_t i = gt; i < (size_t)32 * 48 * 512; i += gn) {
    int c = (int)(i & 511); size_t r = i >> 9; int s = (int)(r % 48); int b = (int)(r / 48);
    p.KNs[((size_t)b * SKV + 2064 + s) * 512 + c] = 0;
  }
  for (size_t i = gt; i < (size_t)32 * 512 * 48; i += gn) {
    int s = (int)(i % 48); size_t r = i / 48;
    p.VTs[r * SKV + 2064 + s] = 0;
  }
}

#define NR 4
__device__ __forceinline__ void norm_mod(const Params& p, int which) {
  const int tid = otid(), lane = tid & 63, w = tid >> 6;
  const float* nwp = which ? p.norm2 : p.norm1;
  u16* dst = which ? p.H : p.H1;
  for (int row0 = (obid() * 8 + w) * NR; row0 < NT; row0 += gridDim.x * 8 * NR) {
    const float* xr = which ? p.out + (size_t)row0 * 1024
                            : (row0 < NP ? p.x_prompt + (size_t)row0 * 1024 : p.x_sample + (size_t)(row0 - NP) * 1024);
    f32x4 v[NR][4]; float ss[NR];
#pragma unroll
    for (int r = 0; r < NR; ++r)
#pragma unroll
      for (int i = 0; i < 4; ++i) v[r][i] = __builtin_nontemporal_load((const f32x4*)(xr + r * 1024 + i * 256 + lane * 4));
#pragma unroll
    for (int r = 0; r < NR; ++r) {
      ss[r] = 0.f;
#pragma unroll
      for (int i = 0; i < 4; ++i) ss[r] += v[r][i].x * v[r][i].x + v[r][i].y * v[r][i].y + v[r][i].z * v[r][i].z + v[r][i].w * v[r][i].w;
    }
#pragma unroll
    for (int o = 32; o > 0; o >>= 1) {
#pragma unroll
      for (int r = 0; r < NR; ++r) ss[r] += __shfl_xor(ss[r], o);
    }
    const float* md = p.mod + bidx_of(row0) * 6144 + (which ? 3072 : 0);
#pragma unroll
    for (int i = 0; i < 4; ++i) {
      const int col = i * 256 + lane * 4;
      const f32x4 nw = *(const f32x4*)(nwp + col), sh = *(const f32x4*)(md + col), sc = *(const f32x4*)(md + 1024 + col);
#pragma unroll
      for (int r = 0; r < NR; ++r) {
        const float rstd = rsqrtf(ss[r] * (1.0f / 1024.0f) + 1e-6f);
        float h0 = v[r][i].x * rstd * nw.x * (1.f + sc.x) + sh.x;
        float h1 = v[r][i].y * rstd * nw.y * (1.f + sc.y) + sh.y;
        float h2 = v[r][i].z * rstd * nw.z * (1.f + sc.z) + sh.z;
        float h3 = v[r][i].w * rstd * nw.w * (1.f + sc.w) + sh.w;
        u32x2 o; o.x = pack2(h0, h1); o.y = pack2(h2, h3);
        *(u32x2*)(dst + (size_t)(row0 + r) * 1024 + col) = o;
      }
    }
  }
}

__device__ __forceinline__ void final_norm(const Params& p) {
  const int tid = otid(), lane = tid & 63, w = tid >> 6;
  for (int row0 = (obid() * 8 + w) * NR; row0 < NT; row0 += gridDim.x * 8 * NR) {
    float* xr = p.out + (size_t)row0 * 1024;
    f32x4 v[NR][4]; float ss[NR];
#pragma unroll
    for (int r = 0; r < NR; ++r)
#pragma unroll
      for (int i = 0; i < 4; ++i) v[r][i] = __builtin_nontemporal_load((const f32x4*)(xr + r * 1024 + i * 256 + lane * 4));
#pragma unroll
    for (int r = 0; r < NR; ++r) {
      ss[r] = 0.f;
#pragma unroll
      for (int i = 0; i < 4; ++i) ss[r] += v[r][i].x * v[r][i].x + v[r][i].y * v[r][i].y + v[r][i].z * v[r][i].z + v[r][i].w * v[r][i].w;
    }
#pragma unroll
    for (int o = 32; o > 0; o >>= 1) {
#pragma unroll
      for (int r = 0; r < NR; ++r) ss[r] += __shfl_xor(ss[r], o);
    }
#pragma unroll
    for (int i = 0; i < 4; ++i) {
      const int col = i * 256 + lane * 4;
      const f32x4 nw = *(const f32x4*)(p.final_norm + col);
#pragma unroll
      for (int r = 0; r < NR; ++r) {
        const float rstd = rsqrtf(ss[r] * (1.0f / 1024.0f) + 1e-6f);
        f32x4 o; o.x = v[r][i].x * rstd * nw.x; o.y = v[r][i].y * rstd * nw.y; o.z = v[r][i].z * rstd * nw.z; o.w = v[r][i].w * rstd * nw.w;
        __builtin_nontemporal_store(o, (f32x4*)(xr + r * 1024 + col));
      }
    }
  }
}

__device__ __forceinline__ void rowpost(const Params& p) {
  const int tid = otid(), lane = tid & 63, w = tid >> 6;
  for (int row0 = (obid() * 8 + w) * 2; row0 < NT; row0 += gridDim.x * 16) {
    u16 rq[2][6], rk[2][4], rx1[2], rx2[2]; float cs[2], sn[2];
#pragma unroll
    for (int r = 0; r < 2; ++r) {
      const u16* z = p.Z + (size_t)(row0 + r) * LDZ;
#pragma unroll
      for (int i = 0; i < 6; ++i) rq[r][i] = z[i * 64 + lane];
#pragma unroll
      for (int i = 0; i < 4; ++i) rk[r][i] = z[ZKV + i * 64 + lane];
      rx1[r] = z[ZKR + (lane & 15)]; rx2[r] = z[ZKR + 16 + (lane & 15)];
      const int pos = pos_of(row0 + r);
      cs[r] = p.tab[pos * 32 + (lane & 15)]; sn[r] = p.tab[pos * 32 + 16 + (lane & 15)];
    }
    float qn[6], kn[4];
#pragma unroll
    for (int i = 0; i < 6; ++i) qn[i] = p.q_norm[i * 64 + lane];
#pragma unroll
    for (int i = 0; i < 4; ++i) kn[i] = p.kv_norm[i * 64 + lane];
#pragma unroll
    for (int r = 0; r < 2; ++r) {
      const int row = row0 + r;
      u16* z = p.Z + (size_t)row * LDZ;
      float q[6], k[4]; float sq = 0.f, sk = 0.f;
#pragma unroll
      for (int i = 0; i < 6; ++i) { q[i] = bf2f(rq[r][i]); sq += q[i] * q[i]; }
#pragma unroll
      for (int i = 0; i < 4; ++i) { k[i] = bf2f(rk[r][i]); sk += k[i] * k[i]; }
#pragma unroll
      for (int o = 32; o > 0; o >>= 1) { sq += __shfl_xor(sq, o); sk += __shfl_xor(sk, o); }
      const float rq_ = rsqrtf(sq * (1.0f / 384.0f) + 1e-6f), rk_ = rsqrtf(sk * (1.0f / 256.0f) + 1e-6f);
#pragma unroll
      for (int i = 0; i < 6; ++i) z[i * 64 + lane] = f2bf(q[i] * rq_ * qn[i]);
      float* o = row < NP ? p.out + O_CKVP + (size_t)row * 256 : p.out + O_CKVS + (size_t)(row - NP) * 256;
#pragma unroll
      for (int i = 0; i < 4; ++i) {
        const float c = k[i] * rk_ * kn[i];
        o[i * 64 + lane] = c;
        z[ZKV + i * 64 + lane] = f2bf(c);
      }
      if (lane < 16) {
        const float x1 = bf2f(rx1[r]), x2 = bf2f(rx2[r]);
        const float o1 = x1 * cs[r] - x2 * sn[r], o2 = x1 * sn[r] + x2 * cs[r];
        if (row < NP) {
          float* ko = p.out + O_KRP + (size_t)row * 32;
          ko[lane] = o1; ko[16 + lane] = o2;
          z[ZKR + lane] = f2bf(o1); z[ZKR + 16 + lane] = f2bf(o2);
        } else {
          float* ko = p.out + O_KRS + (size_t)(row - NP) * 32;
          ko[lane] = o1; ko[16 + lane] = o2;
          const int bs = (row - NP) >> 4, t = (row - NP) & 15;
          u16* kr = p.KRs + ((size_t)bs * SKV + 2048 + t) * 32;
          kr[lane] = f2bf(o1); kr[16 + lane] = f2bf(o2);
        }
      }
    }
  }
}

namespace pg8 {
constexpr int BM = 256, BK = 64, HALF = 128, HTB = HALF * BK * 2, NXCD = 8, WGM = 8;
__device__ __forceinline__ int lds_byte(int r, int c) { const int st = (r >> 4) * 2 + (c >> 5), rr = r & 15, cc = c & 31, ob = rr * 64 + cc * 2; return st * 1024 + (ob ^ (((ob >> 9) & 1) << 5)); }
__device__ __forceinline__ void stage_rc(int b, int& R, int& C) { const int st = b / 1024, sb = b % 1024, swz = sb ^ (((sb >> 9) & 1) << 5); R = (st >> 1) * 16 + swz / 64; C = (st & 1) * 32 + (swz % 64) / 2; }
struct Unit { int pm, pn; };
struct Gemm { const u16* A; int lda; const u16* Bt; int K, nM, nN; };
struct StaticOrder {
  int nM, nN, nwg, G, c;
  __device__ __forceinline__ void init(int nM_, int nN_, int G_, int c_) { nM = nM_; nN = nN_; nwg = nM * nN; G = G_; c = c_; }
  __device__ __forceinline__ bool next(int i, Unit& u) const {
    const long L = (long)i * G + c; if (L >= nwg) return false;
    int wgid = (int)L; { const int q = nwg / NXCD, r = nwg % NXCD, xcd = wgid % NXCD, off = wgid / NXCD; wgid = (xcd < r ? xcd * (q + 1) : r * (q + 1) + (xcd - r) * q) + off; }
    const int nig = WGM * nN, gid = wgid / nig, fm = gid * WGM, gsz = (nM - fm) < WGM ? (nM - fm) : WGM;
    u.pm = fm + ((wgid % nig) % gsz); u.pn = (wgid % nig) / gsz; return true;
  }
};

template <class Epi>
__device__ __forceinline__ void gemm_phase(LAS unsigned char* lds, const Gemm g, const Epi& E) {
  const int tid = otid(), wid = __builtin_amdgcn_readfirstlane(tid >> 6), lane = tid & 63, wr = wid >> 2, wc = wid & 3, fr = lane & 15, fq = lane >> 4;
  int K_ = g.K; asm volatile("" : "+s"(K_));
  const int K = K_, nt = K / BK;
  StaticOrder S; S.init(g.nM, g.nN, (int)gridDim.x, obid());
  unsigned voffA[2], voffB[2];
#pragma unroll
  for (int i = 0; i < 2; ++i) { int R, C; stage_rc(tid * 16 + i * 8192, R, C);
    voffA[i] = (unsigned)(R * g.lda + C) * 2u; voffB[i] = (unsigned)(R * K + C) * 2u; }
  const size_t kstep = (size_t)(BK * 2);
  const size_t hstepA = (size_t)HALF * g.lda * 2, hstepB = (size_t)HALF * K * 2;
  const size_t tstepA = 2 * hstepA, tstepB = 2 * hstepB;
  const unsigned ldsw = (unsigned)wid * 1024u;
  const int aoff = lds_byte(wr * 64 + fr, fq * 8), boff = lds_byte(wc * 32 + fr, fq * 8);
#define PG8_SA(b, h) (((b) * 2 + (h)) * HTB)
#define PG8_SB(b, h) ((4 + (b) * 2 + (h)) * HTB)
#define PG8_STAGE(bufoff, gbase, voff) do { _Pragma("unroll") for (int _i = 0; _i < 2; ++_i) \
        __builtin_amdgcn_global_load_lds((const unsigned*)((const char*)(gbase) + (voff)[_i]), (LAS unsigned*)(lds + (bufoff) + ldsw + _i * 8192), 16, 0, 0); } while (0)
#define PG8_LDA(dst, b, h) do { _Pragma("unroll") for (int m = 0; m < 4; ++m) _Pragma("unroll") for (int k = 0; k < 2; ++k) dst[m][k] = *(const LAS bf16x8*)(lds + PG8_SA(b, h) + aoff + m * 2048 + k * 1024); } while (0)
#define PG8_LDB(dst, b, h) do { _Pragma("unroll") for (int n = 0; n < 2; ++n) _Pragma("unroll") for (int k = 0; k < 2; ++k) dst[n][k] = *(const LAS bf16x8*)(lds + PG8_SB(b, h) + boff + n * 2048 + k * 1024); } while (0)
#define PG8_MMA(ai, bj, At, Bt) do { __builtin_amdgcn_s_setprio(1); _Pragma("unroll") for (int m = 0; m < 4; ++m) _Pragma("unroll") for (int n = 0; n < 2; ++n) _Pragma("unroll") for (int k = 0; k < 2; ++k) \
        acc[ai][bj][m][n] = __builtin_amdgcn_mfma_f32_16x16x32_bf16(Bt[n][k], At[m][k], acc[ai][bj][m][n], 0, 0, 0); __builtin_amdgcn_s_setprio(0); } while (0)
#define PG8_WAIT_V(n) asm volatile("s_waitcnt vmcnt(" #n ")" ::: "memory")
#define PG8_WAIT_L(n) asm volatile("s_waitcnt lgkmcnt(" #n ")" ::: "memory")
#define PG8_BAR __builtin_amdgcn_s_barrier()
#define PG8_SCHED __builtin_amdgcn_sched_barrier(0)
  Unit cur, nxt; int ui = 0;
  if (!S.next(0, cur)) return;
  f32x4 acc[2][2][4][2];
#pragma unroll
  for (int a = 0; a < 2; ++a)
#pragma unroll
    for (int b = 0; b < 2; ++b)
#pragma unroll
      for (int m = 0; m < 4; ++m)
#pragma unroll
        for (int n = 0; n < 2; ++n) acc[a][b][m][n] = (f32x4){0.f, 0.f, 0.f, 0.f};
  bf16x8 At[4][2], B0[2][2], B1[2][2];
  const char* cA = (const char*)g.A + (size_t)cur.pm * tstepA; const char* cB = (const char*)g.Bt + (size_t)cur.pn * tstepB;
  PG8_WAIT_V(0);
  PG8_STAGE(PG8_SB(0, 0), cB, voffB); PG8_STAGE(PG8_SA(0, 0), cA, voffA); PG8_STAGE(PG8_SB(0, 1), cB + hstepB, voffB); PG8_STAGE(PG8_SA(0, 1), cA + hstepA, voffA);
  if (wr == 1) PG8_BAR;
  PG8_WAIT_V(4); PG8_BAR;
  PG8_STAGE(PG8_SB(1, 0), cB + kstep, voffB); PG8_STAGE(PG8_SA(1, 0), cA + kstep, voffA); PG8_STAGE(PG8_SB(1, 1), cB + hstepB + kstep, voffB);
  PG8_WAIT_V(6); PG8_BAR;
  for (;;) {
    const bool has_next = S.next(ui + 1, nxt);
    const char* nA = has_next ? (const char*)g.A + (size_t)nxt.pm * tstepA : cA; const char* nB = has_next ? (const char*)g.Bt + (size_t)nxt.pn * tstepB : cB;
#pragma unroll 1
    for (int t = 0; t < nt; t += 2) {
      const bool last = (t == nt - 2);
      const char* a1 = cA + (size_t)(t + 1) * kstep;
      const char* a2 = last ? nA : cA + (size_t)(t + 2) * kstep; const char* b2 = last ? nB : cB + (size_t)(t + 2) * kstep;
      const char* a3 = a2 + kstep; const char* b3 = b2 + kstep;
      PG8_LDB(B0, 0, 0); PG8_SCHED; PG8_LDA(At, 0, 0); PG8_STAGE(PG8_SA(1, 1), a1 + hstepA, voffA);
      PG8_WAIT_L(8); PG8_BAR; PG8_WAIT_L(0); PG8_MMA(0, 0, At, B0); PG8_BAR; PG8_SCHED;
      PG8_LDB(B1, 0, 1); PG8_STAGE(PG8_SB(0, 0), b2, voffB);
      PG8_BAR; PG8_WAIT_L(0); PG8_MMA(0, 1, At, B1); PG8_BAR;
      PG8_LDA(At, 0, 1); PG8_STAGE(PG8_SA(0, 0), a2, voffA);
      PG8_BAR; PG8_WAIT_L(0); PG8_MMA(1, 0, At, B0); PG8_BAR; PG8_SCHED;
      PG8_STAGE(PG8_SB(0, 1), b2 + hstepB, voffB);
      PG8_WAIT_V(6); PG8_BAR; PG8_MMA(1, 1, At, B1); PG8_BAR;
      PG8_LDB(B0, 1, 0); PG8_SCHED; PG8_LDA(At, 1, 0); PG8_STAGE(PG8_SA(0, 1), a2 + hstepA, voffA);
      PG8_WAIT_L(8); PG8_BAR; PG8_WAIT_L(0); PG8_MMA(0, 0, At, B0); PG8_BAR; PG8_SCHED;
      PG8_LDB(B1, 1, 1); PG8_STAGE(PG8_SB(1, 0), b3, voffB);
      PG8_BAR; PG8_WAIT_L(0); PG8_MMA(0, 1, At, B1); PG8_BAR;
      PG8_LDA(At, 1, 1); PG8_STAGE(PG8_SA(1, 0), a3, voffA);
      PG8_BAR; PG8_WAIT_L(0); PG8_MMA(1, 0, At, B0); PG8_BAR; PG8_SCHED;
      PG8_STAGE(PG8_SB(1, 1), b3 + hstepB, voffB);
      PG8_WAIT_V(6); PG8_BAR; PG8_MMA(1, 1, At, B1); PG8_BAR;
    }
    {
      const int rowb = cur.pm * BM + wr * 64 + fr, colb = cur.pn * BM + wc * 32 + fq * 4;
      const typename Epi::UPre up = E.uload(rowb, colb);
#pragma unroll
      for (int ai = 0; ai < 2; ++ai) {
        typename Epi::Pre pre[4][2];
#pragma unroll
        for (int m = 0; m < 4; ++m)
#pragma unroll
          for (int bj = 0; bj < 2; ++bj) pre[m][bj] = E.load(rowb + ai * HALF + m * 16, colb + bj * HALF);
#pragma unroll
        for (int m = 0; m < 4; ++m)
#pragma unroll
          for (int bj = 0; bj < 2; ++bj) {
            E(rowb + ai * HALF + m * 16, colb + bj * HALF, acc[ai][bj][m][0], acc[ai][bj][m][1], pre[m][bj], up, bj);
            if (Epi::SERIAL) __builtin_amdgcn_sched_barrier(0);
          }
      }
    }
    if (!has_next) break;
#pragma unroll
    for (int a = 0; a < 2; ++a)
#pragma unroll
      for (int b = 0; b < 2; ++b)
#pragma unroll
        for (int m = 0; m < 4; ++m)
#pragma unroll
          for (int n = 0; n < 2; ++n) acc[a][b][m][n] = (f32x4){0.f, 0.f, 0.f, 0.f};
    cur = nxt; cA = nA; cB = nB; ++ui;
  }
  PG8_WAIT_V(0);
  if (wr == 0) PG8_BAR;
  PG8_BAR;
#undef PG8_SA
#undef PG8_SB
#undef PG8_STAGE
#undef PG8_LDA
#undef PG8_LDB
#undef PG8_MMA
#undef PG8_WAIT_V
#undef PG8_WAIT_L
#undef PG8_BAR
#undef PG8_SCHED
}
}

#define BP(T, base, byteoff) ((T*)((char*)(base) + (unsigned)(byteoff)))
#define CBP(T, base, byteoff) ((const T*)((const char*)(base) + (unsigned)(byteoff)))
struct NoPre {};
struct EpiZ {
  static constexpr bool SERIAL = false;
  typedef NoPre Pre; typedef NoPre UPre;
  u16* Z;
  __device__ __forceinline__ UPre uload(int, int) const { return UPre{}; }
  __device__ __forceinline__ Pre load(int, int) const { return Pre{}; }
  __device__ __forceinline__ void operator()(int row, int cb, f32x4 v0, f32x4 v1, const Pre&, const UPre&, int) const {
    const unsigned o = ((unsigned)row * LDZ + cb) * 2u;
    if (cb < LDZ) { u32x2 t; t.x = pack2(v0[0], v0[1]); t.y = pack2(v0[2], v0[3]); *BP(u32x2, Z, o) = t; }
    if (cb + 16 < LDZ) { u32x2 t; t.x = pack2(v1[0], v1[1]); t.y = pack2(v1[2], v1[3]); *BP(u32x2, Z, o + 32u) = t; }
  }
};
struct EpiQ {
  static constexpr bool SERIAL = false;
  struct Pre { f32x4 cs, sn; };
  typedef NoPre UPre;
  u16* Q; const float* tab;
  __device__ __forceinline__ UPre uload(int, int) const { return UPre{}; }
  __device__ __forceinline__ Pre load(int row, int cb) const {
    Pre r; r.cs = (f32x4){1.f, 1.f, 1.f, 1.f}; r.sn = (f32x4){0.f, 0.f, 0.f, 0.f};
    if ((cb & ~15) % 96 == 64) {
      const unsigned to = ((unsigned)pos_of(row) * 32 + (cb & 15)) * 4u;
      r.cs = *CBP(f32x4, tab, to); r.sn = *CBP(f32x4, tab, to + 64u);
    }
    return r;
  }
  __device__ __forceinline__ void operator()(int row, int cb, f32x4 v0, f32x4 v1, const Pre& pr, const UPre&, int) const {
    const float sc = 0.1472444460259031f;
    if ((cb & ~15) % 96 == 64) {
#pragma unroll
      for (int j = 0; j < 4; ++j) {
        float x1 = v0[j], x2 = v1[j];
        v0[j] = x1 * pr.cs[j] - x2 * pr.sn[j];
        v1[j] = x1 * pr.sn[j] + x2 * pr.cs[j];
      }
    }
    u32x2 o0, o1;
    o0.x = pack2(v0[0] * sc, v0[1] * sc); o0.y = pack2(v0[2] * sc, v0[3] * sc);
    o1.x = pack2(v1[0] * sc, v1[1] * sc); o1.y = pack2(v1[2] * sc, v1[3] * sc);
    const unsigned o = ((unsigned)row * 768 + cb) * 2u;
    *BP(u32x2, Q, o) = o0;
    *BP(u32x2, Q, o + 32u) = o1;
  }
};
__device__ __forceinline__ void kv_store(u16* kn, u16* vt, unsigned knrow, unsigned vtbase, unsigned vstride, int cb, f32x4 v0, f32x4 v1) {
  const int hd = cb >> 7, wi = cb & 127;
  if (wi < 64) {
    u32x2 o0, o1;
    o0.x = pack2(v0[0], v0[1]); o0.y = pack2(v0[2], v0[3]); o1.x = pack2(v1[0], v1[1]); o1.y = pack2(v1[2], v1[3]);
    const unsigned o = (knrow * 512 + hd * 64 + wi) * 2u;
    *BP(u32x2, kn, o) = o0;
    *BP(u32x2, kn, o + 32u) = o1;
  } else {
    const unsigned o = (vtbase + (unsigned)(hd * 64 + wi - 64) * vstride) * 2u;
#pragma unroll
    for (int j = 0; j < 4; ++j) {
      *BP(u16, vt, o + (unsigned)j * vstride * 2u) = f2bf(v0[j]);
      *BP(u16, vt, o + (unsigned)(16 + j) * vstride * 2u) = f2bf(v1[j]);
    }
  }
}
template <int MODE>
struct EpiKV {
  static constexpr bool SERIAL = false;
  typedef NoPre Pre; typedef NoPre UPre;
  u16 *KNp, *VTp, *KNs, *VTs;
  __device__ __forceinline__ UPre uload(int, int) const { return UPre{}; }
  __device__ __forceinline__ Pre load(int, int) const { return Pre{}; }
  __device__ __forceinline__ void operator()(int row, int cb, f32x4 v0, f32x4 v1, const Pre&, const UPre&, int) const {
    if (MODE == 0 && row < NP) {
      kv_store(KNp, VTp, (unsigned)row, (unsigned)(row >> 14) * 512u * TSEQ + (unsigned)(row & (TSEQ - 1)), TSEQ, cb, v0, v1);
    } else {
      unsigned bs, sx;
      if (MODE == 0) { bs = (unsigned)(row - NP) >> 4; sx = 2048u + ((unsigned)(row - NP) & 15u); } else { bs = (unsigned)row >> 11; sx = (unsigned)row & 2047u; }
      kv_store(KNs, VTs, bs * SKV + sx, bs * 512u * SKV + sx, SKV, cb, v0, v1);
    }
  }
};
struct EpiMixA {
  static constexpr bool SERIAL = false;
  struct Pre { u32x2 g[2]; };
  typedef NoPre UPre;
  const u16* Z; u16* MX;
  __device__ __forceinline__ UPre uload(int, int) const { return UPre{}; }
  __device__ __forceinline__ Pre load(int row, int cb) const {
    Pre r; const unsigned o = ((unsigned)row * LDZ + ZGA + cb) * 2u;
    r.g[0] = *CBP(u32x2, Z, o); r.g[1] = *CBP(u32x2, Z, o + 32u); return r;
  }
  __device__ __forceinline__ void operator()(int row, int cb, f32x4 v0, f32x4 v1, const Pre& pr, const UPre&, int) const {
    f32x4 v[2] = {v0, v1};
#pragma unroll
    for (int n = 0; n < 2; ++n) {
      const u32x2 g = pr.g[n];
      u32x2 o;
      o.x = pack2(sigmoidf_(bflo(g.x)) * v[n][0], sigmoidf_(bfhi(g.x)) * v[n][1]);
      o.y = pack2(sigmoidf_(bflo(g.y)) * v[n][2], sigmoidf_(bfhi(g.y)) * v[n][3]);
      *BP(u32x2, MX, ((unsigned)row * 1024 + cb + n * 16) * 2u) = o;
    }
  }
};
struct EpiMixB {
  static constexpr bool SERIAL = false;
  struct Pre { u32x2 g[2]; u32x2 a[2]; };
  typedef NoPre UPre;
  const u16* Z; u16* MX;
  __device__ __forceinline__ UPre uload(int, int) const { return UPre{}; }
  __device__ __forceinline__ Pre load(int row, int cb) const {
    Pre r; const unsigned o = ((unsigned)row * LDZ + ZGB + cb) * 2u, m = ((unsigned)row * 1024 + cb) * 2u;
    r.g[0] = *CBP(u32x2, Z, o); r.g[1] = *CBP(u32x2, Z, o + 32u);
    r.a[0] = *CBP(u32x2, MX, m); r.a[1] = *CBP(u32x2, MX, m + 32u); return r;
  }
  __device__ __forceinline__ void operator()(int row, int cb, f32x4 v0, f32x4 v1, const Pre& pr, const UPre&, int) const {
    f32x4 v[2] = {v0, v1};
#pragma unroll
    for (int n = 0; n < 2; ++n) {
      const u32x2 g = pr.g[n], a = pr.a[n];
      u32x2 o;
      o.x = pack2(bflo(a.x) + sigmoidf_(bflo(g.x)) * v[n][0], bfhi(a.x) + sigmoidf_(bfhi(g.x)) * v[n][1]);
      o.y = pack2(bflo(a.y) + sigmoidf_(bflo(g.y)) * v[n][2], bfhi(a.y) + sigmoidf_(bfhi(g.y)) * v[n][3]);
      *BP(u32x2, MX, ((unsigned)row * 1024 + cb + n * 16) * 2u) = o;
    }
  }
};
struct EpiRes1 {
  static constexpr bool SERIAL = false;
  struct Pre { f32x4 x[2]; };
  struct UPre { f32x4 g[2][2]; };
  const float *xp, *xs, *mod; float* XR;
  __device__ __forceinline__ UPre uload(int row, int colb) const {
    UPre u; const unsigned go = ((unsigned)bidx_of(row) * 6144 + 2048 + colb) * 4u;
#pragma unroll
    for (int bj = 0; bj < 2; ++bj)
#pragma unroll
      for (int n = 0; n < 2; ++n) u.g[bj][n] = *CBP(f32x4, mod, go + bj * 512u + n * 64u);
    return u;
  }
  __device__ __forceinline__ Pre load(int row, int cb) const {
    Pre r;
    const float* base = row < NP ? xp : xs;
    const unsigned o = ((unsigned)(row < NP ? row : row - NP) * 1024 + cb) * 4u;
    r.x[0] = *CBP(f32x4, base, o); r.x[1] = *CBP(f32x4, base, o + 64u);
    return r;
  }
  __device__ __forceinline__ void operator()(int row, int cb, f32x4 v0, f32x4 v1, const Pre& pr, const UPre& up, int bj) const {
    f32x4 v[2] = {v0, v1};
#pragma unroll
    for (int n = 0; n < 2; ++n) {
      const f32x4 x = pr.x[n], gg = up.g[bj][n]; f32x4 o;
      o.x = x.x + gg.x * v[n][0]; o.y = x.y + gg.y * v[n][1]; o.z = x.z + gg.z * v[n][2]; o.w = x.w + gg.w * v[n][3];
      *BP(f32x4, XR, ((unsigned)row * 1024 + cb + n * 16) * 4u) = o;
    }
  }
};
struct EpiRes2 {
  static constexpr bool SERIAL = false;
  struct Pre { f32x4 x[2]; };
  struct UPre { f32x4 g[2][2]; };
  const float* mod; float* XR;
  __device__ __forceinline__ UPre uload(int row, int colb) const {
    UPre u; const unsigned go = ((unsigned)bidx_of(row) * 6144 + 5120 + colb) * 4u;
#pragma unroll
    for (int bj = 0; bj < 2; ++bj)
#pragma unroll
      for (int n = 0; n < 2; ++n) u.g[bj][n] = *CBP(f32x4, mod, go + bj * 512u + n * 64u);
    return u;
  }
  __device__ __forceinline__ Pre load(int row, int cb) const {
    Pre r; const unsigned o = ((unsigned)row * 1024 + cb) * 4u;
    r.x[0] = *CBP(f32x4, XR, o); r.x[1] = *CBP(f32x4, XR, o + 64u); return r;
  }
  __device__ __forceinline__ void operator()(int row, int cb, f32x4 v0, f32x4 v1, const Pre& pr, const UPre& up, int bj) const {
    f32x4 v[2] = {v0, v1};
#pragma unroll
    for (int n = 0; n < 2; ++n) {
      const f32x4 x = pr.x[n], gg = up.g[bj][n]; f32x4 o;
      o.x = x.x + gg.x * v[n][0]; o.y = x.y + gg.y * v[n][1]; o.z = x.z + gg.z * v[n][2]; o.w = x.w + gg.w * v[n][3];
      *BP(f32x4, XR, ((unsigned)row * 1024 + cb + n * 16) * 4u) = o;
    }
  }
};
struct EpiSwiglu {
  static constexpr bool SERIAL = false;
  typedef NoPre Pre; typedef NoPre UPre;
  u16* ACT;
  __device__ __forceinline__ UPre uload(int, int) const { return UPre{}; }
  __device__ __forceinline__ Pre load(int, int) const { return Pre{}; }
  __device__ __forceinline__ void operator()(int row, int cb, f32x4 v0, f32x4 v1, const Pre&, const UPre&, int) const {
    const int acol = ((cb & ~15) >> 5) * 16 + (cb & 15);
    float r[4];
#pragma unroll
    for (int j = 0; j < 4; ++j) { r[j] = siluf_(v0[j]) * v1[j]; }
    u32x2 o; o.x = pack2(r[0], r[1]); o.y = pack2(r[2], r[3]);
    *BP(u32x2, ACT, ((unsigned)row * 2816 + acol) * 2u) = o;
  }
};

template <class Epi>
__device__ __forceinline__ void sgemm_rows(const u16* __restrict__ A, int lda, const u16* __restrict__ Bt, int K, int N, const Epi& E, float* sred) {
  const int tid = otid(), lane = tid & 63, w = tid >> 6, lr = lane & 15, lg = lane >> 4;
  const int quad = w >> 2, kq = w & 3;
  const int ntr = NS >> 4, T = (N >> 5) * ntr, KL = K >> 2;
  for (int base = obid() * 2; base < T; base += gridDim.x * 2) {
    const int t = base + quad;
    const bool valid = t < T;
    const int tr = t % ntr, tc = t / ntr;
    const int erow = NP + tr * 16 + lr, ecb = tc * 32 + lg * 4;
    f32x4 c0 = {0.f, 0.f, 0.f, 0.f}, c1 = {0.f, 0.f, 0.f, 0.f};
    typename Epi::UPre up; typename Epi::Pre pre;
    if (valid && kq == 0) { up = E.uload(erow, ecb); pre = E.load(erow, ecb); }
    if (valid) {
      const u16* a = A + (size_t)(NP + tr * 16 + lr) * lda + kq * KL + lg * 8;
      const u16* b0 = Bt + (size_t)(tc * 32 + lr) * K + kq * KL + lg * 8;
      const u16* b1 = b0 + (size_t)16 * K;
#pragma unroll 4
      for (int k = 0; k < KL; k += 64) {
        bf16x8 fa[2], fb0[2], fb1[2];
#pragma unroll
        for (int i = 0; i < 2; ++i) { fa[i] = *(const bf16x8*)(a + k + i * 32); fb0[i] = *(const bf16x8*)(b0 + k + i * 32); fb1[i] = *(const bf16x8*)(b1 + k + i * 32); }
#pragma unroll
        for (int i = 0; i < 2; ++i) { c0 = MFMA(fb0[i], fa[i], c0); c1 = MFMA(fb1[i], fa[i], c1); }
      }
    }
    __syncthreads();
    if (kq != 0) {
      float* r = sred + ((quad * 3 + (kq - 1)) * 8) * 64 + lane;
#pragma unroll
      for (int j = 0; j < 4; ++j) { r[j * 64] = c0[j]; r[(4 + j) * 64] = c1[j]; }
    }
    __syncthreads();
    if (kq == 0 && valid) {
#pragma unroll
      for (int q = 0; q < 3; ++q) {
        const float* r = sred + ((quad * 3 + q) * 8) * 64 + lane;
#pragma unroll
        for (int j = 0; j < 4; ++j) { c0[j] += r[j * 64]; c1[j] += r[(4 + j) * 64]; }
      }
      E(erow, ecb, c0, c1, pre, up, 0);
    }
  }
}

template <bool outmode>
__device__ __forceinline__ void hgrn_run(const Params& p, int pairitem, unsigned char* smraw0) {
  const int tidf = otid();
  const int half = tidf >> 8;
  unsigned char* smraw = smraw0 + half * HG_LDS;
  const int item = pairitem * 2 + half;
  u16* sQ = (u16*)smraw;
  u16* sK = sQ + 32 * 136;
  u16* sKT = sK + 32 * 136;
  u16* sVT = sKT + 128 * 40;
  u16* sAtt = sVT + 128 * 40;
  float* sDec = (float*)(sAtt + 32 * 40);
  float* sSq = sDec + 128;
  const int tid = tidf & 255, lane = tid & 63, w = tid >> 6, lr = lane & 15, lg = lane >> 4;
  int h, tok0, nblk, nv; size_t hsbase = 0; const float* s0 = nullptr; float* sout = nullptr; int decidx = 0;
  if (item < 512) {
    const int bh = item >> 6, r = item & 63;
    h = bh & 3; tok0 = (bh >> 2) * TSEQ + r * 256; nblk = 8; nv = 32;
    hsbase = (size_t)item << 14; decidx = item * 128;
    if (outmode) s0 = p.HS + hsbase;
  } else {
    const int si = item - 512, bs = si >> 2;
    h = si & 3; tok0 = NP + bs * 16; nblk = 1; nv = 16;
    s0 = p.state_hgrn + ((size_t)si << 14);
    sout = p.out + O_HSS + ((size_t)si << 14);
  }
  f32x4 accS[8][2];
#pragma unroll
  for (int mt = 0; mt < 8; ++mt)
#pragma unroll
    for (int nt = 0; nt < 2; ++nt) {
      if (s0) {
#pragma unroll
        for (int j = 0; j < 4; ++j) accS[mt][nt][j] = s0[(mt * 16 + lg * 4 + j) * 128 + w * 32 + nt * 16 + lr];
      } else accS[mt][nt] = (f32x4){0.f, 0.f, 0.f, 0.f};
    }
  float* sP = sSq + 128;
  const int cp = tid & 63, tg = tid >> 6;
  const float lb0 = sigmoidf_(p.lb_param[h * 128 + 2 * cp] - p.lb_param[512 + h * 128 + 2 * cp]);
  const float lb1 = sigmoidf_(p.lb_param[h * 128 + 2 * cp + 1] - p.lb_param[512 + h * 128 + 2 * cp + 1]);
  const float om0 = 1.0f - lb0, om1 = 1.0f - lb1;
  float dtot0 = 1.f, dtot1 = 1.f;
  const float hgscale = 0.08838834764831845f;
  unsigned rf[8], rq[8], rv[8];
#define HG_LOAD(BLK)                                                                                           \
  {                                                                                                            \
    const u16* zb_ = p.Z + (size_t)(tok0 + (BLK) * 32 + tg * 8) * LDZ + h * 128 + 2 * cp;                      \
    _Pragma("unroll") for (int i = 0; i < 8; ++i) {                                                            \
      if (tg * 8 + i < nv) {                                                                                   \
        const u16* z = zb_ + (size_t)i * LDZ;                                                                  \
        rf[i] = *(const unsigned*)(z + ZHF); rv[i] = *(const unsigned*)(z + ZHI);                              \
        rq[i] = outmode ? *(const unsigned*)(z + ZHQ) : 0u;                                                    \
      } else { rf[i] = 0u; rv[i] = 0u; rq[i] = 0u; }                                                           \
    }                                                                                                          \
  }
  HG_LOAD(0)

#pragma unroll 1
  for (int blk = 0; blk < nblk; ++blk) {
    const int tb = tok0 + blk * 32;
    {
      float eb0 = 1.f, eb1 = 1.f;
      float q0[8], q1[8], k0[8], k1[8];
#pragma unroll
      for (int i = 0; i < 8; ++i) {
        q0[i] = 0.f; q1[i] = 0.f; k0[i] = 0.f; k1[i] = 0.f;
        if (tg * 8 + i < nv) {
          const float e0 = __expf(-bflo(rf[i])), e1 = __expf(-bfhi(rf[i]));
          const float s0_ = frcp(1.0f + e0), s1_ = frcp(1.0f + e1);
          eb0 *= lb0 + om0 * s0_; eb1 *= lb1 + om1 * s1_;
          k0[i] = om0 * e0 * s0_ * frcp(eb0); k1[i] = om1 * e1 * s1_ * frcp(eb1);
          if (outmode) { q0[i] = siluf_(bflo(rq[i])) * hgscale * eb0; q1[i] = siluf_(bfhi(rq[i])) * hgscale * eb1; }
        }
      }
      sP[tg * 128 + 2 * cp] = eb0; sP[tg * 128 + 2 * cp + 1] = eb1;
      __syncthreads();
      float pre0 = 1.f, pre1 = 1.f;
#pragma unroll
      for (int g = 0; g < 3; ++g) if (g < tg) { pre0 *= sP[g * 128 + 2 * cp]; pre1 *= sP[g * 128 + 2 * cp + 1]; }
      if (tg == 3) { const float d0 = pre0 * eb0, d1 = pre1 * eb1; sDec[2 * cp] = d0; sDec[2 * cp + 1] = d1; dtot0 *= d0; dtot1 *= d1; }
      const float in0 = frcp(pre0), in1 = frcp(pre1);
#pragma unroll
      for (int i = 0; i < 8; ++i) {
        k0[i] *= in0; k1[i] *= in1;
        if (outmode) {
          const int t = tg * 8 + i;
          *(unsigned*)&sQ[t * 136 + 2 * cp] = pack2(q0[i] * pre0, q1[i] * pre1);
          *(unsigned*)&sK[t * 136 + 2 * cp] = pack2(k0[i], k1[i]);
        }
      }
      { u32x4 a = {pack2(k0[0], k0[1]), pack2(k0[2], k0[3]), pack2(k0[4], k0[5]), pack2(k0[6], k0[7])};
        u32x4 c = {pack2(k1[0], k1[1]), pack2(k1[2], k1[3]), pack2(k1[4], k1[5]), pack2(k1[6], k1[7])};
        *(u32x4*)&sKT[(2 * cp) * 40 + tg * 8] = a; *(u32x4*)&sKT[(2 * cp + 1) * 40 + tg * 8] = c; }
      { u32x4 a, c;
        a.x = (rv[0] & 0xffffu) | (rv[1] << 16); a.y = (rv[2] & 0xffffu) | (rv[3] << 16);
        a.z = (rv[4] & 0xffffu) | (rv[5] << 16); a.w = (rv[6] & 0xffffu) | (rv[7] << 16);
        c.x = (rv[0] >> 16) | (rv[1] & 0xffff0000u); c.y = (rv[2] >> 16) | (rv[3] & 0xffff0000u);
        c.z = (rv[4] >> 16) | (rv[5] & 0xffff0000u); c.w = (rv[6] >> 16) | (rv[7] & 0xffff0000u);
        *(u32x4*)&sVT[(2 * cp) * 40 + tg * 8] = a; *(u32x4*)&sVT[(2 * cp + 1) * 40 + tg * 8] = c; }
    }
    __syncthreads();
    if (blk + 1 < nblk) HG_LOAD(blk + 1)
    f32x4 ot[2][2];
    if (outmode) {
      {
        const int si = w & 1, ti = w >> 1;
        f32x4 at = (f32x4){0.f, 0.f, 0.f, 0.f};
#pragma unroll
        for (int ks = 0; ks < 4; ++ks) {
          bf16x8 a = *(const bf16x8*)&sK[(si * 16 + lr) * 136 + ks * 32 + lg * 8];
          bf16x8 b = *(const bf16x8*)&sQ[(ti * 16 + lr) * 136 + ks * 32 + lg * 8];
          at = MFMA(a, b, at);
        }
        const int t = ti * 16 + lr, sb = si * 16 + lg * 4;
        float m0 = (sb + 0 <= t) ? at[0] : 0.f, m1 = (sb + 1 <= t) ? at[1] : 0.f, m2 = (sb + 2 <= t) ? at[2] : 0.f, m3 = (sb + 3 <= t) ? at[3] : 0.f;
        u32x2 o; o.x = pack2(m0, m1); o.y = pack2(m2, m3);
        *(u32x2*)&sAtt[t * 40 + sb] = o;
      }
      __syncthreads();
#pragma unroll
      for (int vt = 0; vt < 2; ++vt)
#pragma unroll
        for (int tt = 0; tt < 2; ++tt) ot[vt][tt] = (f32x4){0.f, 0.f, 0.f, 0.f};
      {
        bf16x8 bq[2];
#pragma unroll
        for (int tt = 0; tt < 2; ++tt) bq[tt] = *(const bf16x8*)&sAtt[(tt * 16 + lr) * 40 + lg * 8];
#pragma unroll
        for (int vt = 0; vt < 2; ++vt) {
          bf16x8 a = *(const bf16x8*)&sVT[(w * 32 + vt * 16 + lr) * 40 + lg * 8];
#pragma unroll
          for (int tt = 0; tt < 2; ++tt) ot[vt][tt] = MFMA(a, bq[tt], ot[vt][tt]);
        }
      }
#pragma unroll
      for (int kk = 0; kk < 4; ++kk) {
        bf16x8 bq[2];
#pragma unroll
        for (int tt = 0; tt < 2; ++tt)
          bq[tt] = cat8(*(const u32x2*)&sQ[(tt * 16 + lr) * 136 + (2 * kk) * 16 + lg * 4],
                        *(const u32x2*)&sQ[(tt * 16 + lr) * 136 + (2 * kk + 1) * 16 + lg * 4]);
#pragma unroll
        for (int vt = 0; vt < 2; ++vt) {
          bf16x8 a = mk8(pack2(accS[2 * kk][vt][0], accS[2 * kk][vt][1]), pack2(accS[2 * kk][vt][2], accS[2 * kk][vt][3]),
                         pack2(accS[2 * kk + 1][vt][0], accS[2 * kk + 1][vt][1]), pack2(accS[2 * kk + 1][vt][2], accS[2 * kk + 1][vt][3]));
#pragma unroll
          for (int tt = 0; tt < 2; ++tt) ot[vt][tt] = MFMA(a, bq[tt], ot[vt][tt]);
        }
      }
    }
    {
      bf16x8 bv[2];
#pragma unroll
      for (int nt = 0; nt < 2; ++nt) bv[nt] = *(const bf16x8*)&sVT[(w * 32 + nt * 16 + lr) * 40 + lg * 8];
#pragma unroll
      for (int mt = 0; mt < 8; ++mt) {
        bf16x8 a = *(const bf16x8*)&sKT[(mt * 16 + lr) * 40 + lg * 8];
        f32x4 dc = *(const f32x4*)&sDec[mt * 16 + lg * 4];
#pragma unroll
        for (int nt = 0; nt < 2; ++nt) {
          f32x4 r = MFMA(a, bv[nt], accS[mt][nt]);
          r[0] *= dc.x; r[1] *= dc.y; r[2] *= dc.z; r[3] *= dc.w;
          accS[mt][nt] = r;
        }
      }
    }
    if (outmode) {
#pragma unroll
      for (int tt = 0; tt < 2; ++tt) {
        float ss = 0.f;
#pragma unroll
        for (int vt = 0; vt < 2; ++vt)
#pragma unroll
          for (int j = 0; j < 4; ++j) ss += ot[vt][tt][j] * ot[vt][tt][j];
        ss += __shfl_xor(ss, 16); ss += __shfl_xor(ss, 32);
        if (lg == 0) sSq[w * 32 + tt * 16 + lr] = ss;
      }
      __syncthreads();
#pragma unroll
      for (int tt = 0; tt < 2; ++tt) {
        const int t = tt * 16 + lr;
        const float tot = sSq[t] + sSq[32 + t] + sSq[64 + t] + sSq[96 + t];
        const float rstd = rsqrtf(tot * (1.0f / 128.0f) + 1e-6f);
        if (t < nv) {
          u16* z = p.Z + (size_t)(tb + t) * LDZ + h * 128;
#pragma unroll
          for (int vt = 0; vt < 2; ++vt) {
            const int vch = w * 32 + vt * 16 + lg * 4;
            u32x2 g = *(const u32x2*)(z + ZHG + vch);
            f32x4 nw = *(const f32x4*)(p.hg_norm + vch);
            float g0 = bflo(g.x), g1 = bfhi(g.x), g2 = bflo(g.y), g3 = bfhi(g.y);
            float r0 = ot[vt][tt][0] * rstd * nw.x * siluf_(g0);
            float r1 = ot[vt][tt][1] * rstd * nw.y * siluf_(g1);
            float r2 = ot[vt][tt][2] * rstd * nw.z * siluf_(g2);
            float r3 = ot[vt][tt][3] * rstd * nw.w * siluf_(g3);
            u32x2 o; o.x = pack2(r0, r1); o.y = pack2(r2, r3);
            *(u32x2*)(z + ZHQ + vch) = o;
          }
        }
      }
    }
    __syncthreads();
  }
  if (!outmode) {
#pragma unroll
    for (int mt = 0; mt < 8; ++mt)
#pragma unroll
      for (int nt = 0; nt < 2; ++nt)
#pragma unroll
        for (int j = 0; j < 4; ++j) p.HS[hsbase + (mt * 16 + lg * 4 + j) * 128 + w * 32 + nt * 16 + lr] = accS[mt][nt][j];
    if (tg == 3) { p.DEC[decidx + 2 * cp] = dtot0; p.DEC[decidx + 2 * cp + 1] = dtot1; }
  } else if (sout) {
#pragma unroll
    for (int mt = 0; mt < 8; ++mt)
#pragma unroll
      for (int nt = 0; nt < 2; ++nt)
#pragma unroll
        for (int j = 0; j < 4; ++j) sout[(mt * 16 + lg * 4 + j) * 128 + w * 32 + nt * 16 + lr] = accS[mt][nt][j];
  }
}

__device__ __forceinline__ void hgrn_scan(const Params& p, int it) {
  const int e = it * NTHR + otid();
  const int bh = e >> 14, rem = e & 16383, kch = rem >> 7;
  float S = 0.f;
#pragma unroll 1
  for (int r0 = 0; r0 < 64; r0 += 16) {
    float L[16], d[16];
#pragma unroll
    for (int i = 0; i < 16; ++i) {
      L[i] = p.HS[((size_t)(bh * 64 + r0 + i) << 14) + rem];
      d[i] = p.DEC[(bh * 64 + r0 + i) * 128 + kch];
    }
#pragma unroll
    for (int i = 0; i < 16; ++i) {
      p.HS[((size_t)(bh * 64 + r0 + i) << 14) + rem] = S;
      S = d[i] * S + L[i];
    }
  }
  p.out[O_HSP + e] = S;
}

typedef __attribute__((ext_vector_type(16))) float f32x16;
#define MFMA32(a, b, c) __builtin_amdgcn_mfma_f32_32x32x16_bf16((a), (b), (c), 0, 0, 0)
__device__ __forceinline__ void attn_prompt(const Params& p, int item, unsigned char* smraw) {
  u16* sb0 = (u16*)smraw;
  const int tid = otid(), lane = tid & 63, w = tid >> 6, lq = lane & 31, hh = lane >> 5;
  const int qb = 63 - (item >> 4), bh = item & 15, b = bh >> 3, h = bh & 7;
  const int ntr = 2 * qb + 2;
  const int nvis = 4 * qb + (w >> 1) + 1;
  const int q0 = b * TSEQ + qb * 256 + w * 32;
  bf16x8 qf[6];
#pragma unroll
  for (int ks = 0; ks < 6; ++ks) qf[ks] = *(const bf16x8*)(p.Q + (size_t)(q0 + lq) * 768 + h * 96 + ks * 16 + hh * 8);
  f32x16 ot[2];
#pragma unroll
  for (int dt = 0; dt < 2; ++dt)
#pragma unroll
    for (int r = 0; r < 16; ++r) ot[dt][r] = 0.f;
  float nm = 0.f, lrun = 0.f;
  bool first = true;
  u32x4 rk[2], rr, rv[2];
#define ATT_BUF_U16 22016
#define ATT_LOAD(TR)                                                                                          \
  {                                                                                                           \
    const int kb_ = b * TSEQ + (TR) * 128;                                                                    \
    _Pragma("unroll") for (int i = 0; i < 2; ++i) {                                                           \
      const int c_ = tid + i * 512;                                                                           \
      rk[i] = *(const u32x4*)(p.KNp + (size_t)(kb_ + (c_ >> 3)) * 512 + h * 64 + (c_ & 7) * 8);              \
      rv[i] = *(const u32x4*)(p.VTp + ((size_t)(b * 512 + h * 64 + (c_ >> 4))) * TSEQ + (TR) * 128 + (c_ & 15) * 8); \
    }                                                                                                         \
    rr = *(const u32x4*)(p.Z + (size_t)(kb_ + (tid >> 2)) * LDZ + ZKR + (tid & 3) * 8);                       \
  }
#define ATT_WRITE(BI)                                                                                         \
  {                                                                                                           \
    u16* k_ = sb0 + (BI) * ATT_BUF_U16; u16* v_ = k_ + 128 * 104;                                             \
    _Pragma("unroll") for (int i = 0; i < 2; ++i) {                                                           \
      const int c_ = tid + i * 512;                                                                           \
      *(u32x4*)&k_[(c_ >> 3) * 104 + (c_ & 7) * 8] = rk[i];                                                   \
      u16* vd_ = &v_[(c_ >> 4) * 136 + ((c_ & 15) >> 1) * 16 + (c_ & 1) * 4];     \
      *(u32x2*)vd_ = (u32x2){rv[i].x, rv[i].y}; *(u32x2*)(vd_ + 8) = (u32x2){rv[i].z, rv[i].w};               \
    }                                                                                                         \
    *(u32x4*)&k_[(tid >> 2) * 104 + 64 + (tid & 3) * 8] = rr;                                                 \
  }
  ATT_LOAD(0)
  ATT_WRITE(0)
  ATT_LOAD(1)
  __syncthreads();
#pragma unroll 1
  for (int tr = 0; tr < ntr; ++tr) {
    if (tr + 1 < ntr) ATT_WRITE((tr + 1) & 1)
    if (tr + 2 < ntr) ATT_LOAD(tr + 2)
    const u16* sK = sb0 + (tr & 1) * ATT_BUF_U16;
    const u16* sVT = sK + 128 * 104;
    if (2 * tr >= nvis) { __syncthreads(); continue; }
    const bool halfvis = (2 * tr + 1 >= nvis);
    f32x16 st[4];
    f32x16 nmv;
#pragma unroll
    for (int r = 0; r < 16; ++r) nmv[r] = nm;
#pragma unroll
    for (int kt = 0; kt < 4; ++kt) {
      const bf16x8 kf = *(const bf16x8*)&sK[(kt * 32 + lq) * 104 + hh * 8];
      st[kt] = MFMA32(kf, qf[0], nmv);
    }
#pragma unroll
    for (int ks = 1; ks < 6; ++ks)
#pragma unroll
      for (int kt = 0; kt < 4; ++kt) {
        const bf16x8 kf = *(const bf16x8*)&sK[(kt * 32 + lq) * 104 + ks * 16 + hh * 8];
        st[kt] = MFMA32(kf, qf[ks], st[kt]);
      }
    if (__any(halfvis)) {
#pragma unroll
      for (int kt = 2; kt < 4; ++kt)
#pragma unroll
        for (int r = 0; r < 16; ++r) st[kt][r] = -INFINITY;
    }
    {
      float mx = fmaxf(fmaxf(st[0][0], st[0][1]), st[0][2]);
#pragma unroll
      for (int r = 3; r < 16; r += 2) mx = fmaxf(fmaxf(mx, st[0][r]), st[0][r + 1 < 16 ? r + 1 : r]);
#pragma unroll
      for (int kt = 1; kt < 4; ++kt)
#pragma unroll
        for (int r = 0; r < 16; r += 2) mx = fmaxf(fmaxf(mx, st[kt][r]), st[kt][r + 1]);
      mx = max_x32(mx);
      if (first || __any(mx > 8.0f)) {
        const float delta = first ? mx : fmaxf(mx, 0.f);
#pragma unroll
        for (int kt = 0; kt < 4; ++kt)
#pragma unroll
          for (int r = 0; r < 16; ++r) st[kt][r] -= delta;
        nm -= delta;
        if (!first) {
          const float alpha = EXP2(-delta);
          lrun *= alpha;
#pragma unroll
          for (int dt = 0; dt < 2; ++dt)
#pragma unroll
            for (int r = 0; r < 16; ++r) ot[dt][r] *= alpha;
        }
      }
      float ps0 = 0.f, ps1 = 0.f;
#pragma unroll
      for (int kt = 0; kt < 4; ++kt)
#pragma unroll
        for (int r = 0; r < 16; r += 2) {
          const float e0 = EXP2(st[kt][r]), e1 = EXP2(st[kt][r + 1]);
          st[kt][r] = e0; st[kt][r + 1] = e1;
          ps0 += e0; ps1 += e1;
        }
      lrun += ps0 + ps1;
    }
    first = false;
#pragma unroll
    for (int kt = 0; kt < 4; ++kt)
#pragma unroll
      for (int s2 = 0; s2 < 2; ++s2) {
        const bf16x8 pb = mk8(pack2(st[kt][8 * s2 + 0], st[kt][8 * s2 + 1]), pack2(st[kt][8 * s2 + 2], st[kt][8 * s2 + 3]),
                              pack2(st[kt][8 * s2 + 4], st[kt][8 * s2 + 5]), pack2(st[kt][8 * s2 + 6], st[kt][8 * s2 + 7]));
#pragma unroll
        for (int dt = 0; dt < 2; ++dt) {
          const bf16x8 a = *(const bf16x8*)&sVT[(dt * 32 + lq) * 136 + kt * 32 + 16 * s2 + 8 * hh];
          ot[dt] = MFMA32(a, pb, ot[dt]);
        }
      }
    __syncthreads();
  }
#undef ATT_WRITE
#undef ATT_LOAD
  {
    float l = lrun;
    l += __shfl_xor(l, 32);
    const float inv = 1.0f / l;
    u16* o = p.Z + (size_t)(q0 + lq) * LDZ + h * 64;
#pragma unroll
    for (int dt = 0; dt < 2; ++dt)
#pragma unroll
      for (int rg = 0; rg < 4; ++rg) {
        u32x2 v; v.x = pack2(ot[dt][4 * rg + 0] * inv, ot[dt][4 * rg + 1] * inv); v.y = pack2(ot[dt][4 * rg + 2] * inv, ot[dt][4 * rg + 3] * inv);
        *(u32x2*)(o + dt * 32 + 8 * rg + 4 * hh) = v;
      }
  }
}

__device__ __forceinline__ void attn_sample(const Params& p, int item, unsigned char* smraw) {
  float* sM = (float*)smraw;
  float* sL = sM + 512;
  float* sO = sL + 512;
  const int tid = otid(), lane = tid & 63, w = tid >> 6, lr = lane & 15, lg = lane >> 4;
  const int bs = item >> 3, h = item & 7;
  bf16x8 qf[3];
#pragma unroll
  for (int ks = 0; ks < 3; ++ks) qf[ks] = *(const bf16x8*)(p.Q + (size_t)(NP + bs * 16 + lr) * 768 + h * 96 + ks * 32 + lg * 8);
  f32x4 ot[4];
#pragma unroll
  for (int dt = 0; dt < 4; ++dt) ot[dt] = (f32x4){0.f, 0.f, 0.f, 0.f};
  float mrun = -INFINITY, lrun = 0.f;
  for (int kt = w; kt < 33; kt += 8) {
    const size_t kb = (size_t)bs * SKV + kt * 64;
    f32x4 st[4];
#pragma unroll
    for (int a = 0; a < 4; ++a) st[a] = (f32x4){0.f, 0.f, 0.f, 0.f};
#pragma unroll
    for (int a = 0; a < 4; ++a) {
      const size_t krow = kb + a * 16 + lr;
      bf16x8 k0 = *(const bf16x8*)(p.KNs + krow * 512 + h * 64 + lg * 8);
      bf16x8 k1 = *(const bf16x8*)(p.KNs + krow * 512 + h * 64 + 32 + lg * 8);
      bf16x8 k2 = *(const bf16x8*)(p.KRs + krow * 32 + lg * 8);
      st[a] = MFMA(k0, qf[0], st[a]); st[a] = MFMA(k1, qf[1], st[a]); st[a] = MFMA(k2, qf[2], st[a]);
    }
    if (kt == 32) {
#pragma unroll
      for (int a = 1; a < 4; ++a) st[a] = (f32x4){-INFINITY, -INFINITY, -INFINITY, -INFINITY};
    }
    float mx = st[0][0];
#pragma unroll
    for (int a = 0; a < 4; ++a)
#pragma unroll
      for (int j = 0; j < 4; ++j) mx = fmaxf(mx, st[a][j]);
    mx = fmaxf(mx, __shfl_xor(mx, 16)); mx = fmaxf(mx, __shfl_xor(mx, 32));
    const float mnew = fmaxf(mrun, mx);
    const float alpha = EXP2(mrun - mnew);
    mrun = mnew;
    float ps = 0.f;
#pragma unroll
    for (int a = 0; a < 4; ++a)
#pragma unroll
      for (int j = 0; j < 4; ++j) { float e = EXP2(st[a][j] - mnew); st[a][j] = e; ps += e; }
    lrun = lrun * alpha + ps;
#pragma unroll
    for (int dt = 0; dt < 4; ++dt) { ot[dt][0] *= alpha; ot[dt][1] *= alpha; ot[dt][2] *= alpha; ot[dt][3] *= alpha; }
#pragma unroll
    for (int s = 0; s < 2; ++s) {
      bf16x8 pb = mk8(pack2(st[2 * s][0], st[2 * s][1]), pack2(st[2 * s][2], st[2 * s][3]),
                      pack2(st[2 * s + 1][0], st[2 * s + 1][1]), pack2(st[2 * s + 1][2], st[2 * s + 1][3]));
#pragma unroll
      for (int dt = 0; dt < 4; ++dt) {
        const u16* vr = p.VTs + ((size_t)bs * 512 + h * 64 + dt * 16 + lr) * SKV + kt * 64;
        bf16x8 a = cat8(*(const u32x2*)(vr + (2 * s) * 16 + lg * 4), *(const u32x2*)(vr + (2 * s + 1) * 16 + lg * 4));
        ot[dt] = MFMA(a, pb, ot[dt]);
      }
    }
  }
  lrun += __shfl_xor(lrun, 16); lrun += __shfl_xor(lrun, 32);
  __syncthreads();
  sM[w * 64 + lane] = mrun; sL[w * 64 + lane] = lrun;
#pragma unroll
  for (int dt = 0; dt < 4; ++dt)
#pragma unroll
    for (int j = 0; j < 4; ++j) sO[(w * 16 + dt * 4 + j) * 64 + lane] = ot[dt][j];
  __syncthreads();
  if (w < 4) {
    const int dt = w;
    float mm[8], M = -INFINITY;
#pragma unroll
    for (int i = 0; i < 8; ++i) { mm[i] = sM[i * 64 + lane]; M = fmaxf(M, mm[i]); }
    float L = 0.f;
#pragma unroll
    for (int i = 0; i < 8; ++i) { mm[i] = EXP2(mm[i] - M); L += sL[i * 64 + lane] * mm[i]; }
    const float inv = 1.0f / L;
    float r[4];
#pragma unroll
    for (int j = 0; j < 4; ++j) {
      float a = 0.f;
#pragma unroll
      for (int i = 0; i < 8; ++i) a += sO[(i * 16 + dt * 4 + j) * 64 + lane] * mm[i];
      r[j] = a * inv;
    }
    u32x2 v; v.x = pack2(r[0], r[1]); v.y = pack2(r[2], r[3]);
    *(u32x2*)(p.Z + (size_t)(NP + bs * 16 + lr) * LDZ + h * 64 + dt * 16 + lg * 4) = v;
  }
  __syncthreads();
}

__device__ __forceinline__ void run_phase(const Params& p, int ph, unsigned char* smraw, int* sItem) {
  LAS unsigned char* lds = (LAS unsigned char*)smraw;
  const int tid = otid();
#ifdef ONLY_PHASE
  if (ph != ONLY_PHASE) return;
#endif
  switch (ph) {
    case 0: phase0(p, smraw); break;
    case 1: norm_mod(p, 0); break;
    case 2: {
      { EpiZ e{p.Z}; pg8::Gemm g{p.H1, 1024, p.wt_in, 1024, 130, 19}; pg8::gemm_phase(lds, g, e); }
      { EpiKV<1> e{p.KNp, p.VTp, p.KNs, p.VTs}; pg8::Gemm g{p.CKVb, 256, p.wt_ukv, 256, 256, 4}; pg8::gemm_phase(lds, g, e); }
    } break;
    case 3: {
      rowpost(p);
      for (int it = obid(); it < 256; it += gridDim.x) hgrn_run<false>(p, it, smraw);
    } break;
    case 4: {
#ifndef P4SEL
#define P4SEL 3
#endif
      if (P4SEL & 1) { EpiQ e{p.Q, p.tab}; pg8::Gemm g{p.Z, LDZ, p.wt_uq, 384, 130, 3}; pg8::gemm_phase(lds, g, e); }
      if (P4SEL & 2) { EpiKV<0> e{p.KNp, p.VTp, p.KNs, p.VTs}; pg8::Gemm g{p.Z + ZKV, LDZ, p.wt_ukv, 256, 128, 4}; pg8::gemm_phase(lds, g, e); sgemm_rows(p.Z + ZKV, LDZ, p.wt_ukv, 256, 1024, e, (float*)smraw); }
      for (int it = obid(); it < 256; it += gridDim.x) hgrn_scan(p, it);
    } break;
    case 5: {
      const int total = 1024 + 320 + 256;
      for (;;) {
        __syncthreads();
        if (tid == 0) *sItem = (int)atomicAdd(p.ctr, 1u);
        __syncthreads();
        const int it = *sItem;
        if (it >= total) break;
#ifndef ONLY_ITEM
#define ONLY_ITEM 7
#endif
        if (it < 1024) { if (ONLY_ITEM & 1) attn_prompt(p, it, smraw); }
        else if (it < 1024 + 320) { if (ONLY_ITEM & 2) hgrn_run<true>(p, it - 1024, smraw); }
        else { if (ONLY_ITEM & 4) attn_sample(p, it - 1344, smraw); }
      }
    } break;
    case 6: {
      { EpiMixA e{p.Z, p.H}; pg8::Gemm g{p.Z, LDZ, p.wt_pa, 512, 128, 4}; pg8::gemm_phase(lds, g, e); }
      { EpiMixB e{p.Z, p.H}; pg8::Gemm g{p.Z + ZHQ, LDZ, p.wt_pb, 512, 128, 4}; pg8::gemm_phase(lds, g, e); }
      { EpiMixA e{p.Z, p.H}; sgemm_rows(p.Z, LDZ, p.wt_pa, 512, 1024, e, (float*)smraw); }
      { EpiMixB e{p.Z, p.H}; sgemm_rows(p.Z + ZHQ, LDZ, p.wt_pb, 512, 1024, e, (float*)smraw); }
    } break;
    case 7: { EpiRes1 e{p.x_prompt, p.x_sample, p.mod, p.out}; pg8::Gemm g{p.H, 1024, p.wt_out, 1024, 128, 4}; pg8::gemm_phase(lds, g, e); sgemm_rows(p.H, 1024, p.wt_out, 1024, 1024, e, (float*)smraw); } break;
    case 8: norm_mod(p, 1); break;
    case 9: { EpiSwiglu e{p.Z}; pg8::Gemm g{p.H, 1024, p.wt_gu, 1024, 130, 22}; pg8::gemm_phase(lds, g, e); } break;
    case 10: { EpiRes2 e{p.mod, p.out}; pg8::Gemm g{p.Z, 2816, p.wt_dn, 2816, 128, 4}; pg8::gemm_phase(lds, g, e); sgemm_rows(p.Z, 2816, p.wt_dn, 2816, 1024, e, (float*)smraw); } break;
    case 11: final_norm(p); break;
  }
}

__device__ __forceinline__ void xb_setup(unsigned* bar, volatile unsigned* st) {
  if (threadIdx.x == 0) {
    const unsigned x = xb_xcc_id();
    const unsigned G = gridDim.x;
    unsigned cnt = 0u, mine = 1u, sum = 0u, sp = 0u;
    for (;;) {
      sum = 0u; cnt = 0u; mine = 0u;
#pragma unroll
      for (unsigned j = 0; j < 16; ++j) { const unsigned c = xb_ld(&bar[XB_XCNT(j)]); sum += c; cnt += (c > 0u) ? 1u : 0u; mine = (j == x) ? c : mine; }
      if (sum == G) break;
      __builtin_amdgcn_s_sleep(1);
      if ((++sp & 255u) == 0u) { if (xb_ld(&bar[XB_TMO])) break; if (sp > XB_SPIN_CAP) { atomicAdd(&bar[XB_TMO], 1u); break; } }
    }
    st[0] = mine > 0u ? mine : 1u; st[1] = cnt > 0u ? cnt : 1u; st[2] = x;
  }
  __syncthreads();
}

__global__ void __launch_bounds__(NTHR, 2) mega_kernel(Params p) {
  extern __shared__ __attribute__((aligned(16))) unsigned char smraw[];
  int* sItem = (int*)(smraw + STAGE_BYTES);
  cg::grid_group grid = cg::this_grid();
  volatile unsigned* xst = (volatile unsigned*)(smraw + STAGE_BYTES + 16);
  if (blockIdx.x == 0) for (int i = threadIdx.x; i < 4096; i += NTHR) p.ctr[i] = 0u;
  grid.sync();
  if (threadIdx.x == 0) (void)xb_add(&p.ctr[XB_XCNT(xb_xcc_id())], 1u);
#define DO_PHASE(K) if (p.p0 <= (K) && (K) < p.p1) { run_phase(p, (K), smraw, sItem); if ((K) + 1 < p.p1) { if ((K) == 0) xb_setup(p.ctr, xst); xcd_barrier(p.ctr, xst); } }
  DO_PHASE(0) DO_PHASE(1) DO_PHASE(2) DO_PHASE(3) DO_PHASE(4) DO_PHASE(5)
  DO_PHASE(6) DO_PHASE(7) DO_PHASE(8) DO_PHASE(9) DO_PHASE(10) DO_PHASE(11)
}

extern "C" void kernel_launch(void* const* d_in, const int* in_sizes, int n_in, void* d_out, int out_size,
                              void* d_ws, size_t ws_size, hipStream_t stream) {
  static int grid_blocks = 0;
  if (!grid_blocks) {
    int dev = 0, cus = 0, per_cu = 0;
    (void)hipGetDevice(&dev);
    (void)hipDeviceGetAttribute(&cus, hipDeviceAttributeMultiprocessorCount, dev);
    if (hipFuncSetAttribute((const void*)mega_kernel, hipFuncAttributeMaxDynamicSharedMemorySize, LDS_BYTES) != hipSuccess)
      fprintf(stderr, "kernel_launch: hipFuncSetAttribute failed\n");
    (void)hipOccupancyMaxActiveBlocksPerMultiprocessor(&per_cu, (const void*)mega_kernel, NTHR, LDS_BYTES);
    if (per_cu < 1) fprintf(stderr, "kernel_launch: occupancy query says %d blocks/CU\n", per_cu);
    (void)hipGetLastError();
    grid_blocks = cus > 0 ? cus : 256;
  }
  Params p;
  memset(&p, 0, sizeof(p));
  const float* const* in = (const float* const*)d_in;
  p.x_prompt = in[0]; p.x_sample = in[1]; p.cache_ckv = in[2]; p.cache_krope = in[3]; p.state_hgrn = in[4];
  p.c_prompt = in[5]; p.c_sample = in[6]; p.w_in = in[7]; p.q_norm = in[8]; p.w_uq = in[9]; p.kv_norm = in[10];
  p.w_ukv = in[11]; p.lb_param = in[12]; p.hg_norm = in[13]; p.w_pa = in[14]; p.w_pb = in[15]; p.w_out = in[16];
  p.norm1 = in[17]; p.norm2 = in[18]; p.w_ada = in[19]; p.b_ada = in[20]; p.w_gu = in[21]; p.w_down = in[22];
  p.final_norm = in[23];
  p.out = (float*)d_out;
  unsigned char* ws = (unsigned char*)d_ws;
  size_t off = 0;
  auto take = [&](size_t bytes) { unsigned char* r = ws + off; off += (bytes + 255) & ~(size_t)255; return r; };
  p.wt_in = (u16*)take((size_t)4864 * 1024 * 2);
  p.wt_uq = (u16*)take((size_t)768 * 384 * 2);
  p.wt_ukv = (u16*)take((size_t)1024 * 256 * 2);
  p.wt_pa = (u16*)take((size_t)1024 * 512 * 2);
  p.wt_pb = (u16*)take((size_t)1024 * 512 * 2);
  p.wt_out = (u16*)take((size_t)1024 * 1024 * 2);
  p.wt_gu = (u16*)take((size_t)5632 * 1024 * 2);
  p.wt_dn = (u16*)take((size_t)1024 * 2816 * 2);
  p.mod = (float*)take((size_t)34 * 6144 * 4);
  p.tab = (float*)take((size_t)TSEQ * 32 * 4);
  p.ctr = (unsigned*)take(16384);
  p.DEC = (float*)take((size_t)512 * 128 * 4);
  p.HS = (float*)take((size_t)512 * 16384 * 4);
  p.Z = (u16*)take((size_t)NT * LDZ * 2);
  unsigned char* regS = ws + off;
  p.H = (u16*)regS;
  p.KNs = (u16*)regS;
  p.VTs = p.KNs + (size_t)32 * SKV * 512;
  p.KRs = p.VTs + (size_t)32 * 512 * SKV;
  off += (size_t)32 * SKV * 512 * 2 * 2 + (size_t)32 * SKV * 32 * 2;
  if (off > ws_size) { fprintf(stderr, "kernel_launch: workspace too small: need %zu have %zu\n", off, ws_size); return; }
  p.H1 = (u16*)d_out;
  p.Q = (u16*)d_out;
  p.KNp = p.Q + (size_t)NT * 768;
  p.VTp = p.KNp + (size_t)NP * 512;
  p.CKVb = (u16*)((float*)d_out + O_CKVP);
  p.p0 = 0; p.p1 = NPHASE;
  void* args[] = {&p};
  hipError_t e = hipLaunchCooperativeKernel((void*)mega_kernel, dim3(grid_blocks), dim3(NTHR), args, LDS_BYTES, stream);
  if (e != hipSuccess) fprintf(stderr, "cooperative launch failed: %s (grid %d)\n", hipGetErrorString(e), grid_blocks);
}
```
